# Optimizing an MI355X kernel written in HIP

```python
import math
import jax, jax.numpy as jnp
from jax import lax
import numpy as np

D_MODEL = 1024
BATCH = 4
SEQ = 4096
DEPTH = 1

CHUNK = 64

N_HEADS = D_MODEL // 128
HEAD_DIM = 64
ATT_W = N_HEADS * HEAD_DIM
Q_BLOCK = 128

CONV_C = D_MODEL // 2
CONV_K = 31

PEER_HEADS = 8
PEER_DK = 128
PEER_DHALF = PEER_DK // 2
N_KEYS = 128
N_EXPERTS = N_KEYS * N_KEYS
PEER_TOPK = 16
PEER_BLOCK = 128

ALPHA = (2.0 * DEPTH) ** 0.25
BETA = (8.0 * DEPTH) ** -0.25
LN_EPS = 1e-5

SPLIT_SIZES = (ATT_W, ATT_W, ATT_W, N_HEADS, CONV_C, CONV_C, D_MODEL, D_MODEL)
IN_WIDTH = int(sum(SPLIT_SIZES))

kernel_name = "hybrid_fox_conformer_peer_block"


def layer_norm(x, gain=None, bias=None):
    xf = x.astype(jnp.float32)
    mu = jnp.mean(xf, axis=-1, keepdims=True)
    var = jnp.mean(jnp.square(xf - mu), axis=-1, keepdims=True)
    y = (xf - mu) * lax.rsqrt(var + LN_EPS)
    if gain is not None:
        y = y * gain.astype(jnp.float32) + bias.astype(jnp.float32)
    return y.astype(x.dtype)


def modulate(x, shift, scale):
    return layer_norm(x) * (1.0 + scale) + shift


def fox_attention(q, k, v, logf):
    B, S, H, Dh = q.shape
    nblk = S // Q_BLOCK
    scale = 1.0 / math.sqrt(Dh)
    F = jnp.cumsum(logf.astype(jnp.float32), axis=1).transpose(0, 2, 1)
    qh = q.transpose(0, 2, 1, 3)
    kh = k.transpose(0, 2, 1, 3)
    vh = v.transpose(0, 2, 1, 3)
    qb = qh.reshape(B, H, nblk, Q_BLOCK, Dh).transpose(2, 0, 1, 3, 4)
    Fb = F.reshape(B, H, nblk, Q_BLOCK).transpose(2, 0, 1, 3)
    key_pos = jnp.arange(S)

    def one_block(args):
        qi, Fi, bi = args
        s = jnp.einsum('bhqd,bhkd->bhqk', qi, kh).astype(jnp.float32) * scale
        s = s + Fi[..., :, None] - F[..., None, :]
        q_pos = bi * Q_BLOCK + jnp.arange(Q_BLOCK)
        s = jnp.where(key_pos[None, :] <= q_pos[:, None], s, -jnp.inf)
        p = jax.nn.softmax(s, axis=-1).astype(vh.dtype)
        return jnp.einsum('bhqk,bhkd->bhqd', p, vh)

    o = lax.map(one_block, (qb, Fb, jnp.arange(nblk)))
    return o.transpose(1, 0, 3, 2, 4).reshape(B, S, H * Dh)


def causal_depthwise_conv(x, w, b):
    C = x.shape[-1]
    xp = jnp.pad(x, ((0, 0), (CONV_K - 1, 0), (0, 0)))
    y = lax.conv_general_dilated(xp, w[:, None, :].astype(x.dtype), window_strides=(1,),
                                 padding='VALID', dimension_numbers=('NWC', 'WIO', 'NWC'),
                                 feature_group_count=C)
    return y + b


def peer(h, w_q, sub_keys, u_tab, v_tab):
    B, S, D = h.shape
    T = B * S
    hf = h.reshape(T, D)
    q = (hf @ w_q).reshape(T, PEER_HEADS, 2, PEER_DHALF).astype(jnp.float32)
    scores = jnp.einsum('thpd,pnd->thpn', q, sub_keys.astype(jnp.float32))
    sv, si = lax.top_k(scores, PEER_TOPK)
    cand = (sv[:, :, 0, :, None] + sv[:, :, 1, None, :]).reshape(T, PEER_HEADS, PEER_TOPK * PEER_TOPK)
    cv, ci = lax.top_k(cand, PEER_TOPK)
    ia = ci // PEER_TOPK
    ib = ci % PEER_TOPK
    e_idx = (jnp.take_along_axis(si[:, :, 0], ia, axis=-1) * N_KEYS
             + jnp.take_along_axis(si[:, :, 1], ib, axis=-1))
    gates = jax.nn.softmax(cv, axis=-1)

    nb = T // PEER_BLOCK
    xb = hf.reshape(nb, PEER_BLOCK, D)
    eb = e_idx.reshape(nb, PEER_BLOCK, PEER_HEADS, PEER_TOPK)
    gb = gates.reshape(nb, PEER_BLOCK, PEER_HEADS, PEER_TOPK)

    def one_block(args):
        xi, ei, gi = args
        ue = jnp.take(u_tab, ei, axis=0)
        a = jnp.einsum('thkd,td->thk', ue, xi)
        wgt = (jax.nn.gelu(a.astype(jnp.float32)) * gi).astype(xi.dtype)
        ve = jnp.take(v_tab, ei, axis=0)
        return jnp.einsum('thk,thkd->td', wgt, ve)

    out = lax.map(one_block, (xb, eb, gb))
    return out.reshape(B, S, D)


def setup_inputs(seed: int = 0) -> dict:
    key = jax.random.key(seed)
    ks = jax.random.split(key, 24)
    f32 = jnp.float32
    nrm = lambda k, shp: jax.random.normal(k, shp, f32)
    L, D = DEPTH, D_MODEL
    return {
        "x": nrm(ks[0], (BATCH, SEQ, D)),
        "c": nrm(ks[1], (BATCH, D)),
        "w_mod": nrm(ks[2], (L, D, 6 * D)) * (0.5 * D ** -0.5),
        "b_mod": nrm(ks[3], (L, 6 * D)) * 0.02,
        "w_in": nrm(ks[4], (L, D, IN_WIDTH)) * D ** -0.5,
        "b_f": jax.random.uniform(ks[5], (L, N_HEADS), f32, 1.0, 5.0),
        "conv_w": nrm(ks[6], (L, CONV_K, CONV_C)) * CONV_K ** -0.5,
        "conv_b": nrm(ks[7], (L, CONV_C)) * 0.02,
        "conv_ln_g": 1.0 + 0.02 * nrm(ks[8], (L, CONV_C)),
        "conv_ln_b": 0.02 * nrm(ks[9], (L, CONV_C)),
        "w_attn_out": nrm(ks[10], (L, ATT_W, D)) * (ATT_W ** -0.5 * BETA),
        "w_conv_out": nrm(ks[11], (L, CONV_C, D)) * (CONV_C ** -0.5 * BETA),
        "w_out": nrm(ks[12], (L, D, D)) * (D ** -0.5 * BETA),
        "ln1_g": 1.0 + 0.02 * nrm(ks[13], (L, D)),
        "ln1_b": 0.02 * nrm(ks[14], (L, D)),
        "peer_wq": nrm(ks[15], (L, D, PEER_HEADS * PEER_DK)) * D ** -0.5,
        "peer_sub_keys": nrm(ks[16], (L, 2, N_KEYS, PEER_DHALF)) * PEER_DHALF ** -0.5,
        "peer_u": nrm(ks[17], (L, N_EXPERTS, D)) * D ** -0.5,
        "peer_v": nrm(ks[18], (L, N_EXPERTS, D)) * BETA,
        "ln2_g": 1.0 + 0.02 * nrm(ks[19], (L, D)),
        "ln2_b": 0.02 * nrm(ks[20], (L, D)),
    }


def reference(x, c, w_mod, b_mod, w_in, b_f, conv_w, conv_b, conv_ln_g, conv_ln_b,
              w_attn_out, w_conv_out, w_out, ln1_g, ln1_b, peer_wq, peer_sub_keys,
              peer_u, peer_v, ln2_g, ln2_b):
    B, S, D = x.shape
    offsets = [int(o) for o in np.cumsum(SPLIT_SIZES)[:-1]]
    for l in range(DEPTH):
        mod = (jax.nn.silu(c) @ w_mod[l] + b_mod[l])[:, None, :]
        sh1, sc1, g1, sh2, sc2, g2 = jnp.split(mod, 6, axis=-1)

        u = modulate(x, sh1, sc1)
        z = u @ w_in[l]
        q, k, v, f_logit, ca, cb, ga, gb = jnp.split(z, offsets, axis=-1)
        logf = jax.nn.log_sigmoid((f_logit + b_f[l]).astype(jnp.float32))
        attn = fox_attention(q.reshape(B, S, N_HEADS, HEAD_DIM),
                             k.reshape(B, S, N_HEADS, HEAD_DIM),
                             v.reshape(B, S, N_HEADS, HEAD_DIM), logf)
        y_a = attn @ w_attn_out[l]

        hconv = ca * jax.nn.sigmoid(cb)
        hconv = causal_depthwise_conv(hconv, conv_w[l], conv_b[l])
        hconv = jax.nn.silu(layer_norm(hconv, conv_ln_g[l], conv_ln_b[l]))
        y_b = hconv @ w_conv_out[l]

        merged = jax.nn.sigmoid(ga) * y_a + jax.nn.sigmoid(gb) * y_b
        out = merged @ w_out[l]
        x = layer_norm(ALPHA * x + (1.0 + g1) * out, ln1_g[l], ln1_b[l])

        u2 = modulate(x, sh2, sc2)
        y_p = peer(u2, peer_wq[l], peer_sub_keys[l], peer_u[l], peer_v[l])
        x = layer_norm(ALPHA * x + (1.0 + g2) * y_p, ln2_g[l], ln2_b[l])
    return x
```

```cpp
#include <hip/hip_runtime.h>
#include <hip/hip_bf16.h>
#include <cstdio>
#include <cstdint>
#include <cmath>
namespace pg8 {
#define PG8_LAS __attribute__((address_space(3)))
typedef unsigned short bf16_t;
typedef short bf16x8 __attribute__((ext_vector_type(8)));
typedef float f32x4 __attribute__((ext_vector_type(4)));
typedef unsigned u32x4 __attribute__((ext_vector_type(4)));
constexpr int BM = 256, BK = 64, HALF = 128, HTB = HALF * BK * 2  , STAGE_BYTES = 8 * HTB, NXCD = 8, WGM = 8;

__host__ __device__ __forceinline__ int lds_byte(int r, int c) { const int st = (r >> 4) * 2 + (c >> 5), rr = r & 15, cc = c & 31, ob = rr * 64 + cc * 2; return st * 1024 + (ob ^ (((ob >> 9) & 1) << 5)); }
__host__ __device__ __forceinline__ void stage_rc(int b, int& R, int& C) { const int st = b / 1024, sb = b % 1024, swz = sb ^ (((sb >> 9) & 1) << 5); R = (st >> 1) * 16 + swz / 64; C = (st & 1) * 32 + (swz % 64) / 2; }
__host__ __device__ __forceinline__ int perm32(int rho) { const int n = rho >> 4, i = rho & 15; return 8 * (i >> 2) + 4 * n + (i & 3); }

struct Unit { int pm, pn; };
struct Gemm { const bf16_t* A; const bf16_t* Bt; int M, N, K; };

struct StaticOrder {
    int nM, nN, nwg, G, c;
    __host__ __device__ void init(int M, int N, int G_, int c_) { nM = M / BM; nN = N / BM; nwg = nM * nN; G = G_; c = c_; }
    __host__ __device__ bool next(int i, Unit& u) const {
        const long L = (long)i * G + c; if (L >= nwg) return false;
        int wgid = (int)L; { const int q = nwg / NXCD, r = nwg % NXCD, xcd = wgid % NXCD, off = wgid / NXCD; wgid = (xcd < r ? xcd * (q + 1) : r * (q + 1) + (xcd - r) * q) + off; }
        const int nig = WGM * nN, gid = wgid / nig, fm = gid * WGM, gsz = (nM - fm) < WGM ? (nM - fm) : WGM;
        u.pm = fm + ((wgid % nig) % gsz); u.pn = (wgid % nig) / gsz; return true;
    }
    __device__ __forceinline__ void a_ready(const Unit&) const {}
    __device__ __forceinline__ void done(const Unit&) const {}
};

__device__ __forceinline__ unsigned cvt_pk_bf16(float lo, float hi) { unsigned r; asm volatile("v_cvt_pk_bf16_f32 %0, %1, %2" : "=v"(r) : "v"(lo), "v"(hi)); return r; }
typedef float f32x2 __attribute__((ext_vector_type(2)));
__device__ __forceinline__ float sigm(float x) { return __builtin_amdgcn_rcpf(1.0f + __expf(-x)); }
__device__ __forceinline__ float bflo(unsigned w) { return __uint_as_float(w << 16); }
__device__ __forceinline__ float bfhi(unsigned w) { return __uint_as_float(w & 0xffff0000u); }
__device__ __forceinline__ u32x4 pack8(const f32x4& v0, const f32x4& v1) { u32x4 w; w.x = cvt_pk_bf16(v0[0], v0[1]); w.y = cvt_pk_bf16(v0[2], v0[3]); w.z = cvt_pk_bf16(v1[0], v1[1]); w.w = cvt_pk_bf16(v1[2], v1[3]); return w; }

struct EpiInproj {
    static constexpr bool PERM = true, AFTER_DRAIN = false;
    bf16_t *Q, *G, *SGA; size_t qkv_stride, sg_stride; float qscale;
    __device__ __forceinline__ void operator()(const f32x4 (&acc)[2][2][4][2], const Unit& u, int wr, int wc, int fr, int fq) const {
        const int row0 = u.pm * BM + wr * 64 + fr; const int pn = u.pn;
        if (pn >= 6 && pn < 10) {
            const int ch0 = (pn - 6) * 128 + wc * 32 + 8 * fq;
#pragma unroll
            for (int ai = 0; ai < 2; ++ai)
#pragma unroll
                for (int m = 0; m < 4; ++m) { const int row = row0 + ai * HALF + m * 16; f32x4 g0, g1;
#pragma unroll
                    for (int j = 0; j < 4; ++j) { g0[j] = acc[ai][0][m][0][j] * sigm(acc[ai][1][m][0][j]); g1[j] = acc[ai][0][m][1][j] * sigm(acc[ai][1][m][1][j]); }
                    *(u32x4*)(G + (size_t)row * 512 + ch0) = pack8(g0, g1); }
        } else {
            bf16_t* base; int ldc, colt; float sc = 1.f; bool sg = false;
            if (pn < 6) { base = Q + (size_t)(pn >> 1) * qkv_stride; ldc = 512; colt = (pn & 1) * 256; if (pn < 2) sc = qscale; }
            else { base = SGA + (size_t)((pn - 10) >> 2) * sg_stride; ldc = 1024; colt = ((pn - 10) & 3) * 256; sg = true; }
            const int col0 = colt + wc * 32 + 8 * fq;
#pragma unroll
            for (int ai = 0; ai < 2; ++ai)
#pragma unroll
                for (int m = 0; m < 4; ++m) { bf16_t* rowp = base + (size_t)(row0 + ai * HALF + m * 16) * ldc + col0;
#pragma unroll
                    for (int bj = 0; bj < 2; ++bj) { f32x4 v0 = acc[ai][bj][m][0], v1 = acc[ai][bj][m][1];
                        if (sg) {
#pragma unroll
                            for (int j = 0; j < 4; ++j) { v0[j] = sigm(v0[j]); v1[j] = sigm(v1[j]); } }
                        else { v0 = v0 * sc; v1 = v1 * sc; }
                        *(u32x4*)(rowp + bj * HALF) = pack8(v0, v1); } }
        }
    }
};
template <int MODE> struct EpiGate {
    static constexpr bool PERM = true, AFTER_DRAIN = false;
    const bf16_t* S; bf16_t* O;
    __device__ __forceinline__ void operator()(const f32x4 (&acc)[2][2][4][2], const Unit& u, int wr, int wc, int fr, int fq) const {
        const int row0 = u.pm * BM + wr * 64 + fr; const int col0 = u.pn * BM + wc * 32 + 8 * fq;
#pragma unroll
        for (int ai = 0; ai < 2; ++ai)
#pragma unroll
            for (int m = 0; m < 4; ++m) { const size_t off = (size_t)(row0 + ai * HALF + m * 16) * 1024 + col0;
#pragma unroll
                for (int bj = 0; bj < 2; ++bj) { const u32x4 s = *(const u32x4*)(S + off + bj * HALF); f32x4 v0 = acc[ai][bj][m][0], v1 = acc[ai][bj][m][1];
                    v0[0] *= bflo(s.x); v0[1] *= bfhi(s.x); v0[2] *= bflo(s.y); v0[3] *= bfhi(s.y); v1[0] *= bflo(s.z); v1[1] *= bfhi(s.z); v1[2] *= bflo(s.w); v1[3] *= bfhi(s.w);
                    if (MODE == 1) { const u32x4 t = *(const u32x4*)(O + off + bj * HALF);
                        v0[0] += bflo(t.x); v0[1] += bfhi(t.x); v0[2] += bflo(t.y); v0[3] += bfhi(t.y); v1[0] += bflo(t.z); v1[1] += bfhi(t.z); v1[2] += bflo(t.w); v1[3] += bfhi(t.w); }
                    *(u32x4*)(O + off + bj * HALF) = pack8(v0, v1); } }
    }
};
struct EpiF32 {
    static constexpr bool PERM = false, AFTER_DRAIN = false;
    float* O; int ldc;
    __device__ __forceinline__ void operator()(const f32x4 (&acc)[2][2][4][2], const Unit& u, int wr, int wc, int fr, int fq) const {
        const int row0 = u.pm * BM + wr * 64 + fr; const int col0 = u.pn * BM + wc * 32 + 4 * fq;
#pragma unroll
        for (int ai = 0; ai < 2; ++ai)
#pragma unroll
            for (int m = 0; m < 4; ++m) { float* rowp = O + (size_t)(row0 + ai * HALF + m * 16) * ldc + col0;
#pragma unroll
                for (int bj = 0; bj < 2; ++bj)
#pragma unroll
                    for (int n = 0; n < 2; ++n) *(f32x4*)(rowp + bj * HALF + n * 16) = acc[ai][bj][m][n]; }
    }
};

template <class Epi, class Sched, bool ALIGN_EPI = false, bool SP2 = false>
__device__ __forceinline__ void gemm_phase(PG8_LAS unsigned char* lds, const Gemm g, const Sched& S, const Epi& E) {
    const int tid = threadIdx.x, wid = __builtin_amdgcn_readfirstlane(tid >> 6), lane = tid & 63, wr = wid >> 2, wc = wid & 3, fr = lane & 15, fq = lane >> 4;
    const int K = g.K, nt = K / BK;
    unsigned voffA[2], voffB[2];
#pragma unroll
    for (int i = 0; i < 2; ++i) { int R, C; stage_rc(tid * 16 + i * 8192, R, C); const int Rb = Epi::PERM ? ((R & ~31) + perm32(R & 31)) : R;
        voffA[i] = (unsigned)(R * K + C) * 2u; voffB[i] = (unsigned)(Rb * K + C) * 2u; }
    const size_t kstep = (size_t)(BK * 2);
    const size_t hstep = (size_t)HALF * K * 2;
    const size_t tstep = 2 * hstep;
    const unsigned ldsw = (unsigned)wid * 1024u;
    const int aoff = lds_byte(wr * 64 + fr, fq * 8), boff = lds_byte(wc * 32 + fr, fq * 8);
#define PG8_SA(b, h) (((b) * 2 + (h)) * HTB)
#define PG8_SB(b, h) ((4 + (b) * 2 + (h)) * HTB)
#define PG8_STAGE(bufoff, gbase, voff) do { _Pragma("unroll") for (int _i = 0; _i < 2; ++_i) \
        __builtin_amdgcn_global_load_lds((const unsigned*)((const char*)(gbase) + (voff)[_i]), (PG8_LAS unsigned*)(lds + (bufoff) + ldsw + _i * 8192), 16, 0, 0); } while (0)
#define PG8_LDA(dst, b, h) do { _Pragma("unroll") for (int m = 0; m < 4; ++m) _Pragma("unroll") for (int k = 0; k < 2; ++k) dst[m][k] = *(const PG8_LAS bf16x8*)(lds + PG8_SA(b, h) + aoff + m * 2048 + k * 1024); } while (0)
#define PG8_LDB(dst, b, h) do { _Pragma("unroll") for (int n = 0; n < 2; ++n) _Pragma("unroll") for (int k = 0; k < 2; ++k) dst[n][k] = *(const PG8_LAS bf16x8*)(lds + PG8_SB(b, h) + boff + n * 2048 + k * 1024); } while (0)
#define PG8_MMA(ai, bj, At, Bt) do { __builtin_amdgcn_s_setprio(1); _Pragma("unroll") for (int m = 0; m < 4; ++m) _Pragma("unroll") for (int n = 0; n < 2; ++n) _Pragma("unroll") for (int k = 0; k < 2; ++k) \
        acc[ai][bj][m][n] = __builtin_amdgcn_mfma_f32_16x16x32_bf16(Bt[n][k], At[m][k], acc[ai][bj][m][n], 0, 0, 0); __builtin_amdgcn_s_setprio(0); } while (0)
#define PG8_WAIT_V(n) asm volatile("s_waitcnt vmcnt(" #n ")" ::: "memory")
#define PG8_WAIT_L(n) asm volatile("s_waitcnt lgkmcnt(" #n ")" ::: "memory")
#define PG8_BAR __builtin_amdgcn_s_barrier()
#define PG8_SCHED __builtin_amdgcn_sched_barrier(0)
    Unit cur, nxt; int ui = 0;
    if (!S.next(0, cur)) return;
    f32x4 acc[2][2][4][2];
#pragma unroll
    for (int a = 0; a < 2; ++a)
#pragma unroll
        for (int b = 0; b < 2; ++b)
#pragma unroll
            for (int m = 0; m < 4; ++m)
#pragma unroll
                for (int n = 0; n < 2; ++n) acc[a][b][m][n] = (f32x4){0.f, 0.f, 0.f, 0.f};
    bf16x8 At[4][2], B0[2][2], B1[2][2];
    const char* cA = (const char*)g.A + (size_t)cur.pm * tstep; const char* cB = (const char*)g.Bt + (size_t)cur.pn * tstep;
    S.a_ready(cur);
    if constexpr (SP2) {
        PG8_STAGE(PG8_SB(0, 0), cB, voffB); PG8_STAGE(PG8_SB(0, 1), cB + hstep, voffB); PG8_STAGE(PG8_SA(0, 0), cA, voffA); PG8_STAGE(PG8_SA(0, 1), cA + hstep, voffA);
        if (wr == 1) PG8_BAR;
        PG8_WAIT_V(2); PG8_BAR;
        PG8_STAGE(PG8_SB(1, 0), cB + kstep, voffB); PG8_STAGE(PG8_SA(1, 0), cA + kstep, voffA); PG8_STAGE(PG8_SB(1, 1), cB + hstep + kstep, voffB);
        PG8_WAIT_V(6); PG8_BAR;
    } else {
        PG8_STAGE(PG8_SB(0, 0), cB, voffB); PG8_STAGE(PG8_SA(0, 0), cA, voffA); PG8_STAGE(PG8_SB(0, 1), cB + hstep, voffB); PG8_STAGE(PG8_SA(0, 1), cA + hstep, voffA);
        if (wr == 1) PG8_BAR;
        PG8_WAIT_V(4); PG8_BAR;
        PG8_STAGE(PG8_SB(1, 0), cB + kstep, voffB); PG8_STAGE(PG8_SA(1, 0), cA + kstep, voffA); PG8_STAGE(PG8_SB(1, 1), cB + hstep + kstep, voffB);
        PG8_WAIT_V(6); PG8_BAR;
    }
    for (;;) {
        const bool has_next = S.next(ui + 1, nxt);
        const char* nA = has_next ? (const char*)g.A + (size_t)nxt.pm * tstep : cA; const char* nB = has_next ? (const char*)g.Bt + (size_t)nxt.pn * tstep : cB;
        for (int t = 0; t < nt; t += 2) {
            const bool last = (t == nt - 2);
            const char* a1 = cA + (size_t)(t + 1) * kstep;
            const char* a2 = last ? nA : cA + (size_t)(t + 2) * kstep; const char* b2 = last ? nB : cB + (size_t)(t + 2) * kstep;
            const char* a3 = a2 + kstep; const char* b3 = b2 + kstep;
            if (last && has_next) S.a_ready(nxt);
            if constexpr (SP2) {
            PG8_LDB(B0, 0, 0); PG8_LDB(B1, 0, 1); PG8_SCHED; PG8_LDA(At, 0, 0); PG8_STAGE(PG8_SA(1, 1), a1 + hstep, voffA);
            PG8_WAIT_V(8); PG8_WAIT_L(0); PG8_BAR; PG8_MMA(0, 0, At, B0); PG8_MMA(0, 1, At, B1); PG8_BAR; PG8_SCHED;
            PG8_LDA(At, 0, 1); PG8_STAGE(PG8_SB(0, 0), b2, voffB); PG8_STAGE(PG8_SB(0, 1), b2 + hstep, voffB); PG8_STAGE(PG8_SA(0, 0), a2, voffA);
            PG8_WAIT_V(8); PG8_WAIT_L(0); PG8_BAR; PG8_MMA(1, 0, At, B0); PG8_MMA(1, 1, At, B1); PG8_BAR; PG8_SCHED;
            PG8_LDB(B0, 1, 0); PG8_LDB(B1, 1, 1); PG8_SCHED; PG8_LDA(At, 1, 0); PG8_STAGE(PG8_SA(0, 1), a2 + hstep, voffA);
            PG8_WAIT_V(8); PG8_WAIT_L(0); PG8_BAR; PG8_MMA(0, 0, At, B0); PG8_MMA(0, 1, At, B1); PG8_BAR; PG8_SCHED;
            PG8_LDA(At, 1, 1); PG8_STAGE(PG8_SB(1, 0), b3, voffB); PG8_STAGE(PG8_SB(1, 1), b3 + hstep, voffB); PG8_STAGE(PG8_SA(1, 0), a3, voffA);
            PG8_WAIT_V(8); PG8_WAIT_L(0); PG8_BAR; PG8_MMA(1, 0, At, B0); PG8_MMA(1, 1, At, B1); PG8_BAR; PG8_SCHED;
            } else {
            PG8_LDB(B0, 0, 0); PG8_SCHED; PG8_LDA(At, 0, 0); PG8_STAGE(PG8_SA(1, 1), a1 + hstep, voffA);
            PG8_WAIT_L(8); PG8_BAR; PG8_WAIT_L(0); PG8_MMA(0, 0, At, B0); PG8_BAR; PG8_SCHED;
            PG8_LDB(B1, 0, 1); PG8_STAGE(PG8_SB(0, 0), b2, voffB);
            PG8_BAR; PG8_WAIT_L(0); PG8_MMA(0, 1, At, B1); PG8_BAR;
            PG8_LDA(At, 0, 1); PG8_STAGE(PG8_SA(0, 0), a2, voffA);
            PG8_BAR; PG8_WAIT_L(0); PG8_MMA(1, 0, At, B0); PG8_BAR; PG8_SCHED;
            PG8_STAGE(PG8_SB(0, 1), b2 + hstep, voffB);
            PG8_WAIT_V(6); PG8_BAR; PG8_MMA(1, 1, At, B1); PG8_BAR;
            PG8_LDB(B0, 1, 0); PG8_SCHED; PG8_LDA(At, 1, 0); PG8_STAGE(PG8_SA(0, 1), a2 + hstep, voffA);
            PG8_WAIT_L(8); PG8_BAR; PG8_WAIT_L(0); PG8_MMA(0, 0, At, B0); PG8_BAR; PG8_SCHED;
            PG8_LDB(B1, 1, 1); PG8_STAGE(PG8_SB(1, 0), b3, voffB);
            PG8_BAR; PG8_WAIT_L(0); PG8_MMA(0, 1, At, B1); PG8_BAR;
            PG8_LDA(At, 1, 1); PG8_STAGE(PG8_SA(1, 0), a3, voffA);
            PG8_BAR; PG8_WAIT_L(0); PG8_MMA(1, 0, At, B0); PG8_BAR; PG8_SCHED;
            PG8_STAGE(PG8_SB(1, 1), b3 + hstep, voffB);
            PG8_WAIT_V(6); PG8_BAR; PG8_MMA(1, 1, At, B1); PG8_BAR;
            }
        }
        if constexpr (ALIGN_EPI) { if (wr == 0) PG8_BAR; }
        if constexpr (!Epi::AFTER_DRAIN) { E(acc, cur, wr, wc, fr, fq); S.done(cur); }
        if (!has_next) break;
#pragma unroll
        for (int a = 0; a < 2; ++a)
#pragma unroll
            for (int b = 0; b < 2; ++b)
#pragma unroll
                for (int m = 0; m < 4; ++m)
#pragma unroll
                    for (int n = 0; n < 2; ++n) acc[a][b][m][n] = (f32x4){0.f, 0.f, 0.f, 0.f};
        cur = nxt; cA = nA; cB = nB; ++ui;
        if constexpr (ALIGN_EPI) { if (wr == 1) PG8_BAR; }
    }
    PG8_WAIT_V(0);
    if constexpr (!ALIGN_EPI) { if (wr == 0) PG8_BAR; }
    PG8_BAR;
    if constexpr (Epi::AFTER_DRAIN) { E.fused(acc, cur, wr, wc, fr, fq, lds, wid, lane); S.done(cur); }
#undef PG8_SA
#undef PG8_SB
#undef PG8_STAGE
#undef PG8_LDA
#undef PG8_LDB
#undef PG8_MMA
#undef PG8_WAIT_V
#undef PG8_WAIT_L
#undef PG8_BAR
#undef PG8_SCHED
}
}

#ifndef PG8_SP2
#define PG8_SP2 true
#endif
#ifndef PG8_ALIGN
#define PG8_ALIGN true
#endif
#define GAS __attribute__((address_space(1)))
#define LAS __attribute__((address_space(3)))
typedef unsigned short bf16;
typedef unsigned v4u __attribute__((ext_vector_type(4)));
typedef float f32x4 __attribute__((ext_vector_type(4)));
typedef short bf16x8 __attribute__((ext_vector_type(8)));
typedef GAS unsigned gu32;
typedef GAS unsigned long long gu64;
#define RLX_AGENT __ATOMIC_RELAXED, __HIP_MEMORY_SCOPE_AGENT
#define LDS_WAIT() asm volatile("s_waitcnt lgkmcnt(0)" ::: "memory")
#define VM_WAIT() asm volatile("s_waitcnt vmcnt(0)" ::: "memory")
__device__ __forceinline__ unsigned long long rt() { return __builtin_amdgcn_s_memrealtime(); }
__device__ __forceinline__ unsigned f2bf(float f) { unsigned u = __builtin_bit_cast(unsigned, f); return (u + 0x7fffu + ((u >> 16) & 1u)) >> 16; }
__device__ __forceinline__ unsigned pk2(float lo, float hi) { return f2bf(lo) | (f2bf(hi) << 16); }

#define XB_TMO      128
#define XB_XCNT(j)  (256  + 64 * (j))
#define XB_XSUB(j)  (1280 + 64 * (j))
#define XB_XGEN(j)  (2304 + 64 * (j))
#define XB_TOP      3328
#define XB_TOPGEN   3392
#define XCD_BAR_WORDS 3456
#define XB_SPIN_CAP (1u << 18)

__device__ __forceinline__ unsigned xb_ld(unsigned* p)              { return __hip_atomic_load(p, __ATOMIC_RELAXED, __HIP_MEMORY_SCOPE_AGENT); }
__device__ __forceinline__ unsigned xb_add(unsigned* p, unsigned v) { return __hip_atomic_fetch_add(p, v, __ATOMIC_RELAXED, __HIP_MEMORY_SCOPE_AGENT); }
__device__ __forceinline__ unsigned xb_xcc_id() { return (unsigned)__builtin_amdgcn_s_getreg((3 << 11) | 20) & 0xFu; }
#define XB_SPIN(cond, bar) do { unsigned _sp = 0; while (cond) { __builtin_amdgcn_s_sleep(1); \
    if ((++_sp & 255u) == 0u) { if (xb_ld(&(bar)[XB_TMO])) break; if (_sp > XB_SPIN_CAP) { atomicAdd(&(bar)[XB_TMO], 1u); break; } } } } while (0)

struct XcdBarrier {
    unsigned* bar; unsigned x;
    volatile LAS unsigned* st;
};

__device__ __forceinline__ XcdBarrier xcd_barrier_post(unsigned* bar, volatile LAS unsigned* st) {
    XcdBarrier b; b.bar = bar; b.x = xb_xcc_id(); b.st = st;
    if (threadIdx.x == 0) (void)xb_add(&bar[XB_XCNT(b.x)], 1u);
    return b;
}
__device__ __forceinline__ void xcd_barrier_complete(unsigned* bar, unsigned x, unsigned& nloc, unsigned& nx) {
    const unsigned G = gridDim.x * gridDim.y * gridDim.z;
    unsigned sum, cnt, mine, sp = 0u;
    for (;;) {
        sum = 0u; cnt = 0u; mine = 0u;
#pragma unroll
        for (unsigned j = 0; j < 16; ++j) { const unsigned c = xb_ld(&bar[XB_XCNT(j)]); sum += c; cnt += (c > 0u) ? 1u : 0u; mine = (j == x) ? c : mine; }
        if (sum == G) break;
        __builtin_amdgcn_s_sleep(1);
        if ((++sp & 255u) == 0u) { if (xb_ld(&bar[XB_TMO])) break; if (sp > XB_SPIN_CAP) { atomicAdd(&bar[XB_TMO], 1u); break; } }
    }
    nloc = mine > 0u ? mine : 1u; nx = cnt > 0u ? cnt : 1u;
}

__device__ __forceinline__ void xcd_barrier(const XcdBarrier& b) {
    asm volatile("s_waitcnt vmcnt(0)" ::: "memory");
    __syncthreads();
    if (threadIdx.x == 0) {
        unsigned* bar = b.bar;
        __builtin_amdgcn_s_waitcnt(0);
        unsigned nloc = b.st[0], nx = b.st[1];
        if (nloc == 0u) { xcd_barrier_complete(bar, b.x, nloc, nx); b.st[0] = nloc; b.st[1] = nx; }
        const unsigned old = xb_add(&bar[XB_XSUB(b.x)], 1u);
        const unsigned gen = old / nloc;
        if (old + 1u == (gen + 1u) * nloc) {
            __builtin_amdgcn_fence(__ATOMIC_RELEASE, "agent");
            asm volatile("s_waitcnt vmcnt(0)" ::: "memory");
            const unsigned og = xb_add(&bar[XB_TOP], 1u);
            const unsigned tg = og / nx;
            if (og + 1u == (tg + 1u) * nx) xb_add(&bar[XB_TOPGEN], 1u);
            else XB_SPIN(xb_ld(&bar[XB_TOPGEN]) == tg, bar);
            __builtin_amdgcn_fence(__ATOMIC_ACQUIRE, "agent");
            xb_add(&bar[XB_XGEN(b.x)], 1u);
            asm volatile("s_waitcnt vmcnt(0)" ::: "memory");
        } else {
            XB_SPIN(xb_ld(&bar[XB_XGEN(b.x)]) == gen, bar);
            __builtin_amdgcn_fence(__ATOMIC_ACQUIRE, "agent");
            asm volatile("s_waitcnt vmcnt(0)" ::: "memory");
        }
    }
    __syncthreads();
}

constexpr int NWAVES = 8, NTHR = NWAVES * 64;
constexpr int BATCH = 4, SEQ = 4096, D = 1024, M = BATCH * SEQ, NH = 8, HD = 64, AW = 512, CC = 512, CK = 31;
constexpr int WIN_LD = 4616, NIN = 4608;
constexpr int OFF_F = 1536, OFF_CA = 1544, OFF_CB = 2056, OFF_GA = 2568, OFF_GB = 3592;
constexpr int PH = 8, NKEYS = 128, PDH = 64, TOPK = 16, NSEL = PH * TOPK;
constexpr float LN_EPS = 1e-5f, ALPHA = 1.189207115002721f, LOG2E = 1.4426950408889634f;
constexpr float QSCALE = 0.125f * LOG2E;
constexpr int MODW = 6 * D;

constexpr size_t MiB = 1u << 20;
constexpr size_t WS_CTL = 0, CTL_ZERO_BYTES = 1 * MiB;
constexpr size_t WS_PART = 1 * MiB;
constexpr size_t WS_LOGF = 1 * MiB + 512 * 1024;
constexpr size_t WS_FB = 2 * MiB;
constexpr size_t WS_WIN = 4 * MiB, WS_WA = 13 * MiB, WS_WB = 14 * MiB, WS_WO = 15 * MiB, WS_WQ = 17 * MiB;
constexpr size_t WS_R1 = 20 * MiB;
constexpr size_t WS_Q = 52 * MiB, WS_K = 68 * MiB, WS_V = 84 * MiB, WS_G = 100 * MiB, WS_HC = 116 * MiB;
constexpr size_t WS_SGA = 132 * MiB, WS_SGB = 164 * MiB;
constexpr size_t WS_OUTF = 132 * MiB;
constexpr size_t WS_QP = 52 * MiB;
constexpr size_t WS_IDX = 116 * MiB, WS_GATE = 124 * MiB;
constexpr size_t WS_END = 196 * MiB;
constexpr int CW_TMO = 0, CW_CODE = 1, CW_BAR = 4096;

constexpr int RING_OFF = 0, RING_BYTES = 131072;
constexpr int LDSCTL_OFF = RING_BYTES, MISC_OFF = LDSCTL_OFF + 320;
constexpr int LDS_BYTES = 147456;

__device__ __forceinline__ float wave_sum(float v) {
#pragma unroll
    for (int o = 1; o < 64; o <<= 1) v += __shfl_xor(v, o);
    return v;
}
__device__ __forceinline__ float bf_lo(unsigned w) { return __uint_as_float(w << 16); }
__device__ __forceinline__ float bf_hi(unsigned w) { return __uint_as_float(w & 0xffff0000u); }

__device__ __forceinline__ void p0_transpose_item(const float* W, int ldw, int src_col0, bf16* WT, int K, int dst_row0, int k0, LAS float* scr, int lane) {
#pragma unroll 8
    for (int i = 0; i < 32; ++i) { const int kk = 2 * i + (lane >> 5); scr[kk * 33 + (lane & 31)] = W[(size_t)(k0 + kk) * ldw + src_col0 + (lane & 31)]; }
    LDS_WAIT(); asm volatile("" ::: "memory");
    const int c = lane & 7;
#pragma unroll
    for (int j = 0; j < 4; ++j) { const int n = (lane >> 3) + 8 * j; const LAS float* s = scr + (8 * c) * 33 + n;
        v4u o; o.x = pk2(s[0 * 33], s[1 * 33]); o.y = pk2(s[2 * 33], s[3 * 33]); o.z = pk2(s[4 * 33], s[5 * 33]); o.w = pk2(s[6 * 33], s[7 * 33]);
        *(GAS v4u*)(WT + (size_t)(dst_row0 + n) * K + k0 + 8 * c) = o; }
    LDS_WAIT(); asm volatile("" ::: "memory");
}
__device__ __forceinline__ int win_src_col(int r) {
    if (r < 1536) return r;
    if (r < 2560) { const int rr = r - 1536, t = rr >> 8, w = rr & 255; return w < 128 ? OFF_CA + 128 * t + w : OFF_CB + 128 * t + (w - 128); }
    if (r < 3584) return OFF_GA + (r - 2560);
    return OFF_GB + (r - 3584);
}
__device__ __forceinline__ void p0_prologue(LAS unsigned char* lds, const float* const* in, unsigned char* ws, int tid, int lane, int wave, int G) {
    LAS float* sl = (LAS float*)(lds + 98304);
    for (int i = tid; i < BATCH * D; i += NTHR) { const float c = in[1][i]; sl[i] = c / (1.0f + __expf(-c)); }
    __syncthreads();
    LAS float* scr = (LAS float*)(lds + wave * 12288);
    const int gw = (int)blockIdx.x * NWAVES + wave, NGW = G * NWAVES;
    constexpr int I_MOD = 192 * 4, I_WIN = 16 * (NIN / 32), I_WA = 8 * 32, I_WB = 8 * 32, I_WO = 16 * 32, I_WQ = 16 * 32;
    constexpr int NITEMS = I_MOD + I_WIN + I_WA + I_WB + I_WO + I_WQ;
    const float* w_mod = in[2]; const float* b_mod = in[3];
    float* part = (float*)(ws + WS_PART);
    for (int it = gw; it < NITEMS; it += NGW) {
        int r = it;
        if (r < I_MOD) {
            const int chunk = r % 192, kq = r / 192, kk = lane >> 3, cq = lane & 7, col = chunk * 32 + cq * 4;
            f32x4 acc[4];
#pragma unroll
            for (int b = 0; b < 4; ++b) acc[b] = (f32x4){0.f, 0.f, 0.f, 0.f};
#pragma unroll 8
            for (int i = 0; i < 32; ++i) { const int k = kq * 256 + i * 8 + kk; const f32x4 w = *(const GAS f32x4*)(w_mod + (size_t)k * MODW + col);
#pragma unroll
                for (int b = 0; b < 4; ++b) acc[b] += w * sl[b * D + k]; }
#pragma unroll
            for (int b = 0; b < 4; ++b)
#pragma unroll
                for (int j = 0; j < 4; ++j) { float v = acc[b][j]; v += __shfl_xor(v, 8); v += __shfl_xor(v, 16); v += __shfl_xor(v, 32); acc[b][j] = v; }
            if (kk == 0) {
                f32x4 bias = (f32x4){0.f, 0.f, 0.f, 0.f}; if (kq == 0) bias = *(const GAS f32x4*)(b_mod + col);
#pragma unroll
                for (int b = 0; b < 4; ++b) *(GAS f32x4*)(part + (size_t)(kq * 4 + b) * MODW + col) = acc[b] + bias;
            }
            continue;
        }
        r -= I_MOD;
        if (r < I_WIN) { const int kb = r / (NIN / 32), db = r % (NIN / 32); p0_transpose_item(in[4], WIN_LD, win_src_col(32 * db), (bf16*)(ws + WS_WIN), D, 32 * db, 64 * kb, scr, lane); continue; } r -= I_WIN;
        if (r < I_WA) { p0_transpose_item(in[10], D, 32 * (r % 32), (bf16*)(ws + WS_WA), AW, 32 * (r % 32), 64 * (r / 32), scr, lane); continue; } r -= I_WA;
        if (r < I_WB) { p0_transpose_item(in[11], D, 32 * (r % 32), (bf16*)(ws + WS_WB), CC, 32 * (r % 32), 64 * (r / 32), scr, lane); continue; } r -= I_WB;
        if (r < I_WO) { p0_transpose_item(in[12], D, 32 * (r % 32), (bf16*)(ws + WS_WO), D, 32 * (r % 32), 64 * (r / 32), scr, lane); continue; } r -= I_WO;
        p0_transpose_item(in[15], D, 32 * (r % 32), (bf16*)(ws + WS_WQ), D, 32 * (r % 32), 64 * (r / 32), scr, lane);
    }
}
__device__ __forceinline__ void load_mod(LAS float* dst, const float* part, int col0, int ncols, int tid) {
    for (int i = tid; i < BATCH * ncols; i += NTHR) { const int b = i / ncols, c = i % ncols; float s = 0.f;
#pragma unroll
        for (int kq = 0; kq < 4; ++kq) s += part[(size_t)(kq * 4 + b) * MODW + col0 + c];
        dst[i] = s; }
}

__device__ __forceinline__ void p1_ln_pass(LAS unsigned char* lds, const float* const* in, unsigned char* ws, int tid, int lane, int wave, int G) {
    LAS float* modL = (LAS float*)lds;
    LAS float* wfL = (LAS float*)(lds + 32768);
    const float* part = (const float*)(ws + WS_PART);
    load_mod(modL, part, 0, 2048, tid);
    for (int i = tid; i < D * 2; i += NTHR) { const int d = i >> 1, hf = i & 1; *(LAS f32x4*)(wfL + d * 8 + hf * 4) = *(const GAS f32x4*)(in[4] + (size_t)d * WIN_LD + OFF_F + hf * 4); }
    __syncthreads();
    const float* x = in[0]; const float* b_f = in[5];
    bf16* U = (bf16*)(ws + WS_R1); float* logf = (float*)(ws + WS_LOGF);
    const int gw = (int)blockIdx.x * NWAVES + wave, NGW = G * NWAVES;
    for (int m = gw; m < M; m += NGW) {
        const int b = m / SEQ;
        const GAS f32x4* xr = (const GAS f32x4*)(x + (size_t)m * D) + lane;
        f32x4 v[4]; float s = 0.f;
#pragma unroll
        for (int j = 0; j < 4; ++j) { v[j] = xr[64 * j]; s += (v[j].x + v[j].y) + (v[j].z + v[j].w); }
        const float mean = wave_sum(s) * (1.f / D); float s2 = 0.f;
#pragma unroll
        for (int j = 0; j < 4; ++j) { v[j] = v[j] - mean; s2 += (v[j].x * v[j].x + v[j].y * v[j].y) + (v[j].z * v[j].z + v[j].w * v[j].w); }
        const float rstd = 1.f / sqrtf(wave_sum(s2) * (1.f / D) + LN_EPS);
        float f[8];
#pragma unroll
        for (int h = 0; h < 8; ++h) f[h] = 0.f;
        GAS unsigned long long* o8 = (GAS unsigned long long*)(U + (size_t)m * D) + lane;
#pragma unroll
        for (int j = 0; j < 4; ++j) { const int d0 = 256 * j + 4 * lane;
            const f32x4 sh = *(const LAS f32x4*)(modL + b * 2048 + d0), sc = *(const LAS f32x4*)(modL + b * 2048 + 1024 + d0);
            f32x4 u = v[j] * rstd * (sc + 1.0f) + sh;
            o8[64 * j] = (unsigned long long)pk2(u.x, u.y) | ((unsigned long long)pk2(u.z, u.w) << 32);
#pragma unroll
            for (int e = 0; e < 4; ++e) { const f32x4 w0 = *(const LAS f32x4*)(wfL + (d0 + e) * 8), w1 = *(const LAS f32x4*)(wfL + (d0 + e) * 8 + 4);
                f[0] += u[e] * w0.x; f[1] += u[e] * w0.y; f[2] += u[e] * w0.z; f[3] += u[e] * w0.w; f[4] += u[e] * w1.x; f[5] += u[e] * w1.y; f[6] += u[e] * w1.z; f[7] += u[e] * w1.w; } }
#pragma unroll
        for (int h = 0; h < 8; ++h) f[h] = wave_sum(f[h]);
        float fz = f[0];
#pragma unroll
        for (int h = 1; h < 8; ++h) fz = (lane == h) ? f[h] : fz;
        if (lane < 8) { const float z = fz + b_f[lane]; logf[(size_t)m * 8 + lane] = fminf(z, 0.f) - log1pf(expf(-fabsf(z))); }
    }
}

__device__ __forceinline__ void p2_scan(LAS unsigned char* lds, unsigned char* ws, int bh, int tid, int lane, int wave) {
    LAS float* tot = (LAS float*)lds;
    const float* logf = (const float*)(ws + WS_LOGF); float* FB = (float*)(ws + WS_FB);
    const int b = bh >> 3, h = bh & 7;
    float v[8]; float run = 0.f;
#pragma unroll
    for (int k = 0; k < 8; ++k) { run += logf[((size_t)b * SEQ + 8 * tid + k) * 8 + h]; v[k] = run; }
    float inc = run;
#pragma unroll
    for (int o = 1; o < 64; o <<= 1) { const float t = __shfl_up(inc, o); if (lane >= o) inc += t; }
    if (lane == 63) tot[wave] = inc;
    __syncthreads();
    float base = inc - run;
    for (int w = 0; w < wave; ++w) base += tot[w];
#pragma unroll
    for (int k = 0; k < 8; ++k) FB[(size_t)bh * SEQ + 8 * tid + k] = (base + v[k]) * LOG2E;
    __syncthreads();
}

__device__ __forceinline__ void p3_attn_naive_unit(LAS unsigned char* lds, unsigned char* ws, int bh, int qblk, int tid) {
    LAS float* Kt = (LAS float*)lds;
    LAS float* Vt = (LAS float*)(lds + 16384);
    LAS float* Ft = (LAS float*)(lds + 32768);
    const bf16* Q = (const bf16*)(ws + WS_Q); const bf16* K = (const bf16*)(ws + WS_K); const bf16* V = (const bf16*)(ws + WS_V);
    const float* FB = (const float*)(ws + WS_FB) + (size_t)bh * SEQ;
    const int b = bh >> 3, h = bh & 7; const int i = qblk * 512 + tid;
    const size_t rowq = (size_t)b * SEQ + i;
    float q[64], o[64];
    { const GAS v4u* qp = (const GAS v4u*)(Q + rowq * AW + h * HD);
#pragma unroll
      for (int c = 0; c < 8; ++c) { const v4u w = qp[c]; q[8 * c + 0] = bf_lo(w.x); q[8 * c + 1] = bf_hi(w.x); q[8 * c + 2] = bf_lo(w.y); q[8 * c + 3] = bf_hi(w.y); q[8 * c + 4] = bf_lo(w.z); q[8 * c + 5] = bf_hi(w.z); q[8 * c + 6] = bf_lo(w.w); q[8 * c + 7] = bf_hi(w.w); } }
#pragma unroll
    for (int d = 0; d < 64; ++d) o[d] = 0.f;
    const float Fi = FB[i]; float mx = -INFINITY, l = 0.f;
    const int ntile = (qblk * 512 + 512) / 64;
    for (int jt = 0; jt < ntile; ++jt) {
        __syncthreads();
        { const int r = tid >> 3, c = tid & 7; const size_t rowk = (size_t)b * SEQ + jt * 64 + r;
          const v4u kw = *(const GAS v4u*)(K + rowk * AW + h * HD + 8 * c), vw = *(const GAS v4u*)(V + rowk * AW + h * HD + 8 * c);
          LAS float* kd = Kt + r * 64 + 8 * c; LAS float* vd = Vt + r * 64 + 8 * c;
          kd[0] = bf_lo(kw.x); kd[1] = bf_hi(kw.x); kd[2] = bf_lo(kw.y); kd[3] = bf_hi(kw.y); kd[4] = bf_lo(kw.z); kd[5] = bf_hi(kw.z); kd[6] = bf_lo(kw.w); kd[7] = bf_hi(kw.w);
          vd[0] = bf_lo(vw.x); vd[1] = bf_hi(vw.x); vd[2] = bf_lo(vw.y); vd[3] = bf_hi(vw.y); vd[4] = bf_lo(vw.z); vd[5] = bf_hi(vw.z); vd[6] = bf_lo(vw.w); vd[7] = bf_hi(vw.w);
          if (tid < 64) Ft[tid] = FB[jt * 64 + tid]; }
        __syncthreads();
        for (int jj = 0; jj < 64; ++jj) {
            const int j = jt * 64 + jj;
            if (j <= i) {
                float s = 0.f;
#pragma unroll
                for (int c = 0; c < 16; ++c) { const f32x4 kv = *(const LAS f32x4*)(Kt + jj * 64 + 4 * c); s += q[4 * c] * kv.x + q[4 * c + 1] * kv.y + q[4 * c + 2] * kv.z + q[4 * c + 3] * kv.w; }
                s += Fi - Ft[jj];
                if (s > mx) { const float fsc = exp2f(mx - s); l *= fsc;
#pragma unroll
                    for (int d = 0; d < 64; ++d) o[d] *= fsc;
                    mx = s; }
                const float p = exp2f(s - mx); l += p;
#pragma unroll
                for (int c = 0; c < 16; ++c) { const f32x4 vv = *(const LAS f32x4*)(Vt + jj * 64 + 4 * c); o[4 * c] += p * vv.x; o[4 * c + 1] += p * vv.y; o[4 * c + 2] += p * vv.z; o[4 * c + 3] += p * vv.w; }
            }
        }
    }
    const float rl = 1.0f / l;
    { GAS v4u* op = (GAS v4u*)((bf16*)(ws + WS_Q) + rowq * AW + h * HD);
#pragma unroll
      for (int c = 0; c < 8; ++c) { v4u w; w.x = pk2(o[8 * c] * rl, o[8 * c + 1] * rl); w.y = pk2(o[8 * c + 2] * rl, o[8 * c + 3] * rl); w.z = pk2(o[8 * c + 4] * rl, o[8 * c + 5] * rl); w.w = pk2(o[8 * c + 6] * rl, o[8 * c + 7] * rl); op[c] = w; } }
}

__device__ __forceinline__ void p3_conv_unit(LAS unsigned char* lds, const float* const* in, unsigned char* ws, int unit, int tid, int lane, int wave) {
    LAS bf16* gt = (LAS bf16*)lds; LAS float* ct = (LAS float*)(lds + 63488);
    const bf16* Gm = (const bf16*)(ws + WS_G); bf16* HC = (bf16*)(ws + WS_HC);
    const int m0 = unit * 32, s0 = m0 % SEQ;
    __syncthreads();
    for (int i = tid; i < 62 * 64; i += NTHR) { const int r = i >> 6, c8 = i & 63; v4u w = (v4u){0u, 0u, 0u, 0u};
        if (r >= 30 || s0 != 0) w = *(const GAS v4u*)(Gm + (size_t)(m0 - 30 + r) * CC + 8 * c8);
        *(LAS v4u*)(gt + r * 512 + 8 * c8) = w; }
    float w[CK];
#pragma unroll
    for (int k = 0; k < CK; ++k) w[k] = in[6][k * CC + tid];
    const float cb = in[7][tid];
    __syncthreads();
#pragma unroll 1
    for (int g8 = 0; g8 < 4; ++g8) {
        float acc[8];
#pragma unroll
        for (int t = 0; t < 8; ++t) acc[t] = cb;
#pragma unroll
        for (int r = 0; r < 38; ++r) { const float gv = __uint_as_float((unsigned)gt[(g8 * 8 + r) * 512 + tid] << 16);
#pragma unroll
            for (int t = 0; t < 8; ++t) { const int k = r - t; if (k >= 0 && k < CK) acc[t] += w[k] * gv; } }
#pragma unroll
        for (int t = 0; t < 8; ++t) ct[(g8 * 8 + t) * 512 + tid] = acc[t];
    }
    __syncthreads();
    const float* lg = in[8]; const float* lb = in[9];
#pragma unroll 1
    for (int t = 0; t < 4; ++t) { const int tok = wave * 4 + t;
        const f32x4 a0 = *(const LAS f32x4*)(ct + tok * 512 + 8 * lane), a1 = *(const LAS f32x4*)(ct + tok * 512 + 8 * lane + 4);
        const float mean = wave_sum((a0.x + a0.y) + (a0.z + a0.w) + (a1.x + a1.y) + (a1.z + a1.w)) * (1.f / CC);
        const f32x4 d0 = a0 - mean, d1 = a1 - mean;
        const float var = wave_sum((d0.x * d0.x + d0.y * d0.y) + (d0.z * d0.z + d0.w * d0.w) + (d1.x * d1.x + d1.y * d1.y) + (d1.z * d1.z + d1.w * d1.w)) * (1.f / CC);
        const float rstd = 1.f / sqrtf(var + LN_EPS);
        const f32x4 g0 = *(const GAS f32x4*)(lg + 8 * lane), g1 = *(const GAS f32x4*)(lg + 8 * lane + 4), b0 = *(const GAS f32x4*)(lb + 8 * lane), b1 = *(const GAS f32x4*)(lb + 8 * lane + 4);
        f32x4 y0 = d0 * rstd * g0 + b0, y1 = d1 * rstd * g1 + b1;
#pragma unroll
        for (int e = 0; e < 4; ++e) { y0[e] = y0[e] / (1.0f + __expf(-y0[e])); y1[e] = y1[e] / (1.0f + __expf(-y1[e])); }
        v4u o; o.x = pk2(y0.x, y0.y); o.y = pk2(y0.z, y0.w); o.z = pk2(y1.x, y1.y); o.w = pk2(y1.z, y1.w);
        *(GAS v4u*)(HC + (size_t)(m0 + tok) * CC + 8 * lane) = o; }
}

__device__ __forceinline__ void p6_ln_pass(LAS unsigned char* lds, const float* const* in, float* out, unsigned char* ws, int tid, int lane, int wave, int G) {
    LAS float* modL = (LAS float*)lds;
    load_mod(modL, (const float*)(ws + WS_PART), 2048, 3072, tid);
    __syncthreads();
    const float* x = in[0]; const float* outf = (const float*)(ws + WS_OUTF); const float* lg = in[13]; const float* lb = in[14];
    bf16* U2 = (bf16*)(ws + WS_R1);
    const int gw = (int)blockIdx.x * NWAVES + wave, NGW = G * NWAVES;
    for (int m = gw; m < M; m += NGW) {
        const int b = m / SEQ;
        const GAS f32x4* xr = (const GAS f32x4*)(x + (size_t)m * D) + lane; const GAS f32x4* orr = (const GAS f32x4*)(outf + (size_t)m * D) + lane;
        f32x4 v[4]; float s = 0.f;
#pragma unroll
        for (int j = 0; j < 4; ++j) { const f32x4 g1 = *(const LAS f32x4*)(modL + b * 3072 + 256 * j + 4 * lane);
            v[j] = xr[64 * j] * ALPHA + (g1 + 1.0f) * orr[64 * j]; s += (v[j].x + v[j].y) + (v[j].z + v[j].w); }
        float mean = wave_sum(s) * (1.f / D); float s2 = 0.f;
#pragma unroll
        for (int j = 0; j < 4; ++j) { v[j] = v[j] - mean; s2 += (v[j].x * v[j].x + v[j].y * v[j].y) + (v[j].z * v[j].z + v[j].w * v[j].w); }
        float rstd = 1.f / sqrtf(wave_sum(s2) * (1.f / D) + LN_EPS);
        s = 0.f;
        GAS f32x4* x1r = (GAS f32x4*)(out + (size_t)m * D) + lane;
#pragma unroll
        for (int j = 0; j < 4; ++j) { const f32x4 gg = *(const GAS f32x4*)(lg + 256 * j + 4 * lane), bb = *(const GAS f32x4*)(lb + 256 * j + 4 * lane);
            v[j] = v[j] * rstd * gg + bb; x1r[64 * j] = v[j]; s += (v[j].x + v[j].y) + (v[j].z + v[j].w); }
        mean = wave_sum(s) * (1.f / D); s2 = 0.f;
#pragma unroll
        for (int j = 0; j < 4; ++j) { v[j] = v[j] - mean; s2 += (v[j].x * v[j].x + v[j].y * v[j].y) + (v[j].z * v[j].z + v[j].w * v[j].w); }
        rstd = 1.f / sqrtf(wave_sum(s2) * (1.f / D) + LN_EPS);
        GAS unsigned long long* o8 = (GAS unsigned long long*)(U2 + (size_t)m * D) + lane;
#pragma unroll
        for (int j = 0; j < 4; ++j) { const f32x4 sh = *(const LAS f32x4*)(modL + b * 3072 + 1024 + 256 * j + 4 * lane), sc = *(const LAS f32x4*)(modL + b * 3072 + 2048 + 256 * j + 4 * lane);
            const f32x4 u = v[j] * rstd * (sc + 1.0f) + sh;
            o8[64 * j] = (unsigned long long)pk2(u.x, u.y) | ((unsigned long long)pk2(u.z, u.w) << 32); }
    }
}

#define INS16(VA, IA, X, XI) do { float x_ = (X); int xi_ = (XI); _Pragma("unroll") for (int i_ = 0; i_ < 16; ++i_) { const bool gt_ = x_ > VA[i_]; const float tv_ = gt_ ? VA[i_] : x_; const int ti_ = gt_ ? IA[i_] : xi_; \
    VA[i_] = gt_ ? x_ : VA[i_]; IA[i_] = gt_ ? xi_ : IA[i_]; x_ = tv_; xi_ = ti_; } } while (0)
__device__ __forceinline__ void p8_half(const float* qrow, const LAS float* keys, float (&sv)[16], int (&si)[16]) {
    float q[64];
#pragma unroll
    for (int c = 0; c < 16; ++c) { const f32x4 t = *(const GAS f32x4*)(qrow + 4 * c); q[4 * c] = t.x; q[4 * c + 1] = t.y; q[4 * c + 2] = t.z; q[4 * c + 3] = t.w; }
#pragma unroll
    for (int i = 0; i < 16; ++i) { sv[i] = -INFINITY; si[i] = 0; }
#pragma unroll 1
    for (int n = 0; n < NKEYS; ++n) { float s = 0.f;
#pragma unroll
        for (int c = 0; c < 16; ++c) { const f32x4 kv = *(const LAS f32x4*)(keys + n * 64 + 4 * c); s += q[4 * c] * kv.x + q[4 * c + 1] * kv.y + q[4 * c + 2] * kv.z + q[4 * c + 3] * kv.w; }
        INS16(sv, si, s, n); }
}
__device__ __forceinline__ void p8_topk(LAS unsigned char* lds, const float* const* in, unsigned char* ws, int tid, int G) {
    LAS float* keys = (LAS float*)lds;
    for (int i = tid; i < 2 * NKEYS * PDH / 4; i += NTHR) *(LAS f32x4*)(keys + 4 * i) = *(const GAS f32x4*)(in[16] + 4 * i);
    __syncthreads();
    const float* QP = (const float*)(ws + WS_QP); int* IDX = (int*)(ws + WS_IDX); float* GATE = (float*)(ws + WS_GATE);
    for (int unit = (int)blockIdx.x; unit < M / 64; unit += G) {
        const int t = unit * 64 + (tid >> 3), h = tid & 7;
        float sv0[16], sv1[16]; int si0[16], si1[16];
        p8_half(QP + (size_t)t * D + h * 128, keys, sv0, si0);
        p8_half(QP + (size_t)t * D + h * 128 + 64, keys + NKEYS * PDH, sv1, si1);
        float cv[16]; int ce[16];
#pragma unroll
        for (int i = 0; i < 16; ++i) { cv[i] = -INFINITY; ce[i] = 0; }
#pragma unroll
        for (int a = 0; a < 16; ++a)
#pragma unroll
            for (int b = 0; b < 16; ++b) if ((a + 1) * (b + 1) <= 16) INS16(cv, ce, sv0[a] + sv1[b], si0[a] * NKEYS + si1[b]);
        float e[16]; float sum = 0.f;
#pragma unroll
        for (int i = 0; i < 16; ++i) { e[i] = __expf(cv[i] - cv[0]); sum += e[i]; }
        const float rs = 1.0f / sum;
#pragma unroll
        for (int i = 0; i < 16; i += 4) { *(GAS v4u*)(IDX + (size_t)t * NSEL + h * 16 + i) = (v4u){(unsigned)ce[i], (unsigned)ce[i + 1], (unsigned)ce[i + 2], (unsigned)ce[i + 3]};
            *(GAS f32x4*)(GATE + (size_t)t * NSEL + h * 16 + i) = (f32x4){e[i] * rs, e[i + 1] * rs, e[i + 2] * rs, e[i + 3] * rs}; }
    }
}

__device__ __forceinline__ float gelu_tanh(float a) { const float y = 0.7978845608028654f * (a + 0.044715f * a * a * a); const float t = 1.0f - 2.0f / (1.0f + __expf(2.0f * y)); return 0.5f * a * (1.0f + t); }
__device__ __forceinline__ void p9_gather(LAS unsigned char* lds, const float* const* in, float* out, unsigned char* ws, int tid, int lane, int wave, int G) {
    LAS float* g2L = (LAS float*)lds;
    load_mod(g2L, (const float*)(ws + WS_PART), 5120, 1024, tid);
    __syncthreads();
    const bf16* U2 = (const bf16*)(ws + WS_R1); const int* IDX = (const int*)(ws + WS_IDX); const float* GATE = (const float*)(ws + WS_GATE);
    const float* UT = in[17]; const float* VT = in[18]; const float* lg = in[19]; const float* lb = in[20];
    const int gw = (int)blockIdx.x * NWAVES + wave, NGW = G * NWAVES;
    for (int m = gw; m < M; m += NGW) {
        const int b = m / SEQ;
        f32x4 xv[4];
        { const GAS unsigned long long* ur = (const GAS unsigned long long*)(U2 + (size_t)m * D) + lane;
#pragma unroll
          for (int j = 0; j < 4; ++j) { const unsigned long long w = ur[64 * j]; const unsigned lo = (unsigned)w, hi = (unsigned)(w >> 32); xv[j] = (f32x4){bf_lo(lo), bf_hi(lo), bf_lo(hi), bf_hi(hi)}; } }
        const int e0 = IDX[(size_t)m * NSEL + lane], e1 = IDX[(size_t)m * NSEL + 64 + lane];
        const float g0 = GATE[(size_t)m * NSEL + lane], g1 = GATE[(size_t)m * NSEL + 64 + lane];
        float w0 = 0.f, w1 = 0.f;
#pragma unroll 1
        for (int k = 0; k < NSEL; k += 4) {
            f32x4 r[4][4];
#pragma unroll
            for (int i = 0; i < 4; ++i) { const int kk = k + i; const int e = __builtin_amdgcn_readlane(kk < 64 ? e0 : e1, kk & 63);
                const GAS f32x4* up = (const GAS f32x4*)(UT + (size_t)e * D) + lane;
#pragma unroll
                for (int j = 0; j < 4; ++j) r[i][j] = up[64 * j]; }
#pragma unroll
            for (int i = 0; i < 4; ++i) { float s = 0.f;
#pragma unroll
                for (int j = 0; j < 4; ++j) s += (r[i][j].x * xv[j].x + r[i][j].y * xv[j].y) + (r[i][j].z * xv[j].z + r[i][j].w * xv[j].w);
                s = wave_sum(s); const float ge = gelu_tanh(s); const int kk = k + i;
                if (kk < 64) { if (lane == kk) w0 = ge * g0; } else { if (lane == kk - 64) w1 = ge * g1; } }
        }
        f32x4 acc[4];
#pragma unroll
        for (int j = 0; j < 4; ++j) acc[j] = (f32x4){0.f, 0.f, 0.f, 0.f};
#pragma unroll 1
        for (int k = 0; k < NSEL; k += 4) {
            f32x4 r[4][4]; float wk[4];
#pragma unroll
            for (int i = 0; i < 4; ++i) { const int kk = k + i; const int e = __builtin_amdgcn_readlane(kk < 64 ? e0 : e1, kk & 63);
                wk[i] = __uint_as_float(__builtin_amdgcn_readlane(__float_as_uint(kk < 64 ? w0 : w1), kk & 63));
                const GAS f32x4* vp = (const GAS f32x4*)(VT + (size_t)e * D) + lane;
#pragma unroll
                for (int j = 0; j < 4; ++j) r[i][j] = vp[64 * j]; }
#pragma unroll
            for (int i = 0; i < 4; ++i)
#pragma unroll
                for (int j = 0; j < 4; ++j) acc[j] += r[i][j] * wk[i];
        }
        GAS f32x4* xr = (GAS f32x4*)(out + (size_t)m * D) + lane; f32x4 v[4]; float s = 0.f;
#pragma unroll
        for (int j = 0; j < 4; ++j) { const f32x4 g2 = *(const LAS f32x4*)(g2L + b * 1024 + 256 * j + 4 * lane); v[j] = xr[64 * j] * ALPHA + (g2 + 1.0f) * acc[j]; s += (v[j].x + v[j].y) + (v[j].z + v[j].w); }
        const float mean = wave_sum(s) * (1.f / D); float s2 = 0.f;
#pragma unroll
        for (int j = 0; j < 4; ++j) { v[j] = v[j] - mean; s2 += (v[j].x * v[j].x + v[j].y * v[j].y) + (v[j].z * v[j].z + v[j].w * v[j].w); }
        const float rstd = 1.f / sqrtf(wave_sum(s2) * (1.f / D) + LN_EPS);
#pragma unroll
        for (int j = 0; j < 4; ++j) { const f32x4 gg = *(const GAS f32x4*)(lg + 256 * j + 4 * lane), bb = *(const GAS f32x4*)(lb + 256 * j + 4 * lane); xr[64 * j] = v[j] * rstd * gg + bb; }
    }
}

constexpr int NPHASE = 10;
struct Args { const float* in[21]; float* out; unsigned char* ws; int ph_lo, ph_hi; };
__global__ void __launch_bounds__(NTHR, 2) fwd(Args args) {
    extern __shared__ __attribute__((aligned(16))) unsigned char lds_raw[];
    LAS unsigned char* lds = (LAS unsigned char*)lds_raw;
    volatile LAS unsigned* MISC = (volatile LAS unsigned*)(lds + MISC_OFF);
    const int tid = threadIdx.x, lane = tid & 63, wave = __builtin_amdgcn_readfirstlane(tid >> 6), G = gridDim.x;
    unsigned char* ws = args.ws; gu32* ctl = (gu32*)(ws + WS_CTL);
    for (int u = tid; u < (LDS_BYTES - LDSCTL_OFF) / 4; u += NTHR) ((LAS unsigned*)(lds + LDSCTL_OFF))[u] = 0u;
    __syncthreads();
    const int lo = args.ph_lo, hi = args.ph_hi;
    const bool multi = (hi - lo) > 1;
    XcdBarrier bar; bar.bar = (unsigned*)(ctl + CW_BAR); bar.x = 0; bar.st = nullptr;
    if (multi) bar = xcd_barrier_post((unsigned*)(ctl + CW_BAR), MISC + 8);
#define IN(k) (lo <= (k) && (k) < hi)
#define SEAM(k) do { if (IN(k) && IN((k) + 1)) xcd_barrier(bar); } while (0)

    if (IN(0)) { p0_prologue(lds, args.in, ws, tid, lane, wave, G); }
    SEAM(0);
    if (IN(1)) { p1_ln_pass(lds, args.in, ws, tid, lane, wave, G); }
    SEAM(1);
    if (IN(2)) {
        pg8::Gemm g{(const bf16*)(ws + WS_R1), (const bf16*)(ws + WS_WIN), M, NIN, D}; pg8::StaticOrder S; S.init(M, NIN, G, (int)blockIdx.x);
        pg8::EpiInproj E{(bf16*)(ws + WS_Q), (bf16*)(ws + WS_G), (bf16*)(ws + WS_SGA), (WS_K - WS_Q) / 2, (WS_SGB - WS_SGA) / 2, QSCALE};
        pg8::gemm_phase<pg8::EpiInproj, pg8::StaticOrder, true, true>(lds + RING_OFF, g, S, E);
        __syncthreads();
        for (int bh = G - 1 - (int)blockIdx.x; bh < BATCH * NH; bh += G) p2_scan(lds, ws, bh, tid, lane, wave);
    }
    SEAM(2);
    if (IN(3)) {
        for (int u = (int)blockIdx.x; u < 256; u += G) p3_attn_naive_unit(lds, ws, u >> 3, 7 - (u & 7), tid);
        __syncthreads();
        for (int u = (int)blockIdx.x; u < M / 32; u += G) p3_conv_unit(lds, args.in, ws, u, tid, lane, wave);
    }
    SEAM(3);
    if (IN(4)) {
        pg8::StaticOrder S; S.init(M, D, G, (int)blockIdx.x);
        { pg8::Gemm g{(const bf16*)(ws + WS_Q), (const bf16*)(ws + WS_WA), M, D, AW}; pg8::EpiGate<0> E{(const bf16*)(ws + WS_SGA), (bf16*)(ws + WS_R1)};
          pg8::gemm_phase<pg8::EpiGate<0>, pg8::StaticOrder, true, true>(lds + RING_OFF, g, S, E); }
        __syncthreads();
        { pg8::Gemm g{(const bf16*)(ws + WS_HC), (const bf16*)(ws + WS_WB), M, D, CC}; pg8::EpiGate<1> E{(const bf16*)(ws + WS_SGB), (bf16*)(ws + WS_R1)};
          pg8::gemm_phase<pg8::EpiGate<1>, pg8::StaticOrder, true, true>(lds + RING_OFF, g, S, E); }
    }
    SEAM(4);
    if (IN(5)) {
        pg8::Gemm g{(const bf16*)(ws + WS_R1), (const bf16*)(ws + WS_WO), M, D, D}; pg8::StaticOrder S; S.init(M, D, G, (int)blockIdx.x);
        pg8::EpiF32 E{(float*)(ws + WS_OUTF), D};
        pg8::gemm_phase<pg8::EpiF32, pg8::StaticOrder, true, true>(lds + RING_OFF, g, S, E);
    }
    SEAM(5);
    if (IN(6)) { p6_ln_pass(lds, args.in, args.out, ws, tid, lane, wave, G); }
    SEAM(6);
    if (IN(7)) {
        pg8::Gemm g{(const bf16*)(ws + WS_R1), (const bf16*)(ws + WS_WQ), M, D, D}; pg8::StaticOrder S; S.init(M, D, G, (int)blockIdx.x);
        pg8::EpiF32 E{(float*)(ws + WS_QP), D};
        pg8::gemm_phase<pg8::EpiF32, pg8::StaticOrder, true, true>(lds + RING_OFF, g, S, E);
    }
    SEAM(7);
    if (IN(8)) { p8_topk(lds, args.in, ws, tid, G); }
    SEAM(8);
    if (IN(9)) { p9_gather(lds, args.in, args.out, ws, tid, lane, wave, G); }
#undef IN
#undef SEAM
}

#ifndef MK_ONE_LAUNCH
#define MK_ONE_LAUNCH 0
#endif
extern "C" void kernel_launch(void* const* d_in, const int* in_sizes, int n_in, void* d_out, int out_size, void* d_ws, size_t ws_size, hipStream_t stream) {
    static int grid = 0;
    if (grid == 0) {
        if (n_in != 21 || out_size != M * D || ws_size < WS_END) { fprintf(stderr, "kernel_launch: unexpected problem shape (n_in %d, out %d, ws %zu)\n", n_in, out_size, ws_size); grid = -1; return; }
        int dev = 0, cus = 0, per_cu = 0;
        if (hipGetDevice(&dev) != hipSuccess || hipDeviceGetAttribute(&cus, hipDeviceAttributeMultiprocessorCount, dev) != hipSuccess) { grid = -1; return; }
        if (hipFuncSetAttribute((const void*)fwd, hipFuncAttributeMaxDynamicSharedMemorySize, LDS_BYTES) != hipSuccess) { fprintf(stderr, "kernel_launch: hipFuncSetAttribute failed\n"); grid = -1; return; }
        if (hipOccupancyMaxActiveBlocksPerMultiprocessor(&per_cu, (const void*)fwd, NTHR, LDS_BYTES) != hipSuccess || per_cu < 1) { fprintf(stderr, "kernel_launch: occupancy query says %d\n", per_cu); }
        (void)hipGetLastError();
        grid = cus;
    }
    if (grid < 0) return;
    if (hipMemsetAsync((char*)d_ws + WS_CTL, 0, CTL_ZERO_BYTES, stream) != hipSuccess) return;
    Args a{};
    for (int i = 0; i < 21; ++i) a.in[i] = (const float*)d_in[i];
    a.out = (float*)d_out; a.ws = (unsigned char*)d_ws;
#if MK_ONE_LAUNCH
    a.ph_lo = 0; a.ph_hi = NPHASE;
    hipLaunchKernelGGL(fwd, dim3(grid), dim3(NTHR), LDS_BYTES, stream, a);
#else
    for (int p = 0; p < NPHASE; ++p) { a.ph_lo = p; a.ph_hi = p + 1; hipLaunchKernelGGL(fwd, dim3(grid), dim3(NTHR), LDS_BYTES, stream, a); }
#endif
}
```

```cpp
#include <hip/hip_runtime.h>
#include <hip/hip_bf16.h>
#include <cstdio>
#include <cstdint>
#include <cmath>
namespace pg8 {
#define PG8_LAS __attribute__((address_space(3)))
typedef unsigned short bf16_t;
typedef short bf16x8 __attribute__((ext_vector_type(8)));
typedef float f32x4 __attribute__((ext_vector_type(4)));
typedef unsigned u32x4 __attribute__((ext_vector_type(4)));
constexpr int BM = 256, BK = 64, HALF = 128, HTB = HALF * BK * 2  , STAGE_BYTES = 8 * HTB, NXCD = 8, WGM = 8;

__host__ __device__ __forceinline__ int lds_byte(int r, int c) { const int st = (r >> 4) * 2 + (c >> 5), rr = r & 15, cc = c & 31, ob = rr * 64 + cc * 2; return st * 1024 + (ob ^ (((ob >> 9) & 1) << 5)); }
__host__ __device__ __forceinline__ void stage_rc(int b, int& R, int& C) { const int st = b / 1024, sb = b % 1024, swz = sb ^ (((sb >> 9) & 1) << 5); R = (st >> 1) * 16 + swz / 64; C = (st & 1) * 32 + (swz % 64) / 2; }
__host__ __device__ __forceinline__ int perm32(int rho) { const int n = rho >> 4, i = rho & 15; return 8 * (i >> 2) + 4 * n + (i & 3); }

struct Unit { int pm, pn; };
struct Gemm { const bf16_t* A; const bf16_t* Bt; int M, N, K; };

struct StaticOrder {
    int nM, nN, nwg, G, c;
    __host__ __device__ void init(int M, int N, int G_, int c_) { nM = M / BM; nN = N / BM; nwg = nM * nN; G = G_; c = c_; }
    __host__ __device__ bool next(int i, Unit& u) const {
        const long L = (long)i * G + c; if (L >= nwg) return false;
        int wgid = (int)L; { const int q = nwg / NXCD, r = nwg % NXCD, xcd = wgid % NXCD, off = wgid / NXCD; wgid = (xcd < r ? xcd * (q + 1) : r * (q + 1) + (xcd - r) * q) + off; }
        const int nig = WGM * nN, gid = wgid / nig, fm = gid * WGM, gsz = (nM - fm) < WGM ? (nM - fm) : WGM;
        u.pm = fm + ((wgid % nig) % gsz); u.pn = (wgid % nig) / gsz; return true;
    }
    __device__ __forceinline__ void a_ready(const Unit&) const {}
    __device__ __forceinline__ void done(const Unit&) const {}
};

__device__ __forceinline__ unsigned cvt_pk_bf16(float lo, float hi) { unsigned r; asm volatile("v_cvt_pk_bf16_f32 %0, %1, %2" : "=v"(r) : "v"(lo), "v"(hi)); return r; }
typedef float f32x2 __attribute__((ext_vector_type(2)));
__device__ __forceinline__ float sigm(float x) { return __builtin_amdgcn_rcpf(1.0f + __expf(-x)); }
__device__ __forceinline__ float bflo(unsigned w) { return __uint_as_float(w << 16); }
__device__ __forceinline__ float bfhi(unsigned w) { return __uint_as_float(w & 0xffff0000u); }
__device__ __forceinline__ u32x4 pack8(const f32x4& v0, const f32x4& v1) { u32x4 w; w.x = cvt_pk_bf16(v0[0], v0[1]); w.y = cvt_pk_bf16(v0[2], v0[3]); w.z = cvt_pk_bf16(v1[0], v1[1]); w.w = cvt_pk_bf16(v1[2], v1[3]); return w; }

struct EpiInproj {
    static constexpr bool PERM = true, AFTER_DRAIN = false;
    bf16_t *Q, *G, *SGA; size_t qkv_stride, sg_stride; float qscale;
    unsigned* km2h;
    __device__ __forceinline__ void operator()(const f32x4 (&acc)[2][2][4][2], const Unit& u, int wr, int wc, int fr, int fq) const {
        const int row0 = u.pm * BM + wr * 64 + fr; const int pn = u.pn;
        if (pn >= 6 && pn < 10) {
            const int ch0 = (pn - 6) * 128 + wc * 32 + 8 * fq;
#pragma unroll
            for (int ai = 0; ai < 2; ++ai)
#pragma unroll
                for (int m = 0; m < 4; ++m) { const int row = row0 + ai * HALF + m * 16; f32x4 g0, g1;
#pragma unroll
                    for (int j = 0; j < 4; ++j) { g0[j] = acc[ai][0][m][0][j] * sigm(acc[ai][1][m][0][j]); g1[j] = acc[ai][0][m][1][j] * sigm(acc[ai][1][m][1][j]); }
                    *(u32x4*)(G + (size_t)row * 512 + ch0) = pack8(g0, g1); }
        } else {
            bf16_t* base; int ldc, colt; float sc = 1.f; bool sg = false;
            if (pn < 6) { base = Q + (size_t)(pn >> 1) * qkv_stride; ldc = 512; colt = (pn & 1) * 256; if (pn < 2) sc = qscale; }
            else { base = SGA + (size_t)((pn - 10) >> 2) * sg_stride; ldc = 1024; colt = ((pn - 10) & 3) * 256; sg = true; }
            const int col0 = colt + wc * 32 + 8 * fq;
            if (pn == 2 || pn == 3) {
#pragma unroll
                for (int bj = 0; bj < 2; ++bj) { float mx = 0.f;
#pragma unroll
                    for (int ai = 0; ai < 2; ++ai)
#pragma unroll
                        for (int m = 0; m < 4; ++m) { const f32x4 a = acc[ai][bj][m][0], b = acc[ai][bj][m][1]; float ss = (a[0] * a[0] + a[1] * a[1]) + (a[2] * a[2] + a[3] * a[3]) + (b[0] * b[0] + b[1] * b[1]) + (b[2] * b[2] + b[3] * b[3]);
                            { const auto r = __builtin_amdgcn_permlane16_swap(__float_as_uint(ss), __float_as_uint(ss), false, false); ss = __uint_as_float(r[0]) + __uint_as_float(r[1]); }
                            { const auto r = __builtin_amdgcn_permlane32_swap(__float_as_uint(ss), __float_as_uint(ss), false, false); ss = __uint_as_float(r[0]) + __uint_as_float(r[1]); }
                            mx = fmaxf(mx, ss); }
#pragma unroll
                    for (int o = 1; o < 16; o <<= 1) mx = fmaxf(mx, __shfl_xor(mx, o));
                    if ((threadIdx.x & 63) == 0) __hip_atomic_fetch_max(km2h + (((u.pm >> 4) * 8 + (pn - 2) * 4 + 2 * bj + (wc >> 1)) * 2 + (wc & 1)), __float_as_uint(mx * 1.02f), __ATOMIC_RELAXED, __HIP_MEMORY_SCOPE_AGENT); }
            }
#pragma unroll
            for (int ai = 0; ai < 2; ++ai)
#pragma unroll
                for (int m = 0; m < 4; ++m) { bf16_t* rowp = base + (size_t)(row0 + ai * HALF + m * 16) * ldc + col0;
#pragma unroll
                    for (int bj = 0; bj < 2; ++bj) { f32x4 v0 = acc[ai][bj][m][0], v1 = acc[ai][bj][m][1];
                        if (sg) {
#pragma unroll
                            for (int j = 0; j < 4; ++j) { v0[j] = sigm(v0[j]); v1[j] = sigm(v1[j]); } }
                        else { v0 = v0 * sc; v1 = v1 * sc; }
                        *(u32x4*)(rowp + bj * HALF) = pack8(v0, v1); } }
        }
    }
};
template <int MODE> struct EpiGate {
    static constexpr bool PERM = true, AFTER_DRAIN = false;
    const bf16_t* S; bf16_t* O;
    __device__ __forceinline__ void operator()(const f32x4 (&acc)[2][2][4][2], const Unit& u, int wr, int wc, int fr, int fq) const {
        const int row0 = u.pm * BM + wr * 64 + fr; const int col0 = u.pn * BM + wc * 32 + 8 * fq;
#pragma unroll
        for (int ai = 0; ai < 2; ++ai)
#pragma unroll
            for (int m = 0; m < 4; ++m) { const size_t off = (size_t)(row0 + ai * HALF + m * 16) * 1024 + col0;
#pragma unroll
                for (int bj = 0; bj < 2; ++bj) { const u32x4 s = *(const u32x4*)(S + off + bj * HALF); f32x4 v0 = acc[ai][bj][m][0], v1 = acc[ai][bj][m][1];
                    v0[0] *= bflo(s.x); v0[1] *= bfhi(s.x); v0[2] *= bflo(s.y); v0[3] *= bfhi(s.y); v1[0] *= bflo(s.z); v1[1] *= bfhi(s.z); v1[2] *= bflo(s.w); v1[3] *= bfhi(s.w);
                    if (MODE == 1) { const u32x4 t = *(const u32x4*)(O + off + bj * HALF);
                        v0[0] += bflo(t.x); v0[1] += bfhi(t.x); v0[2] += bflo(t.y); v0[3] += bfhi(t.y); v1[0] += bflo(t.z); v1[1] += bfhi(t.z); v1[2] += bflo(t.w); v1[3] += bfhi(t.w); }
                    *(u32x4*)(O + off + bj * HALF) = pack8(v0, v1); } }
    }
};
struct EpiF32 {
    static constexpr bool PERM = false, AFTER_DRAIN = false;
    float* O; int ldc;
    __device__ __forceinline__ void operator()(const f32x4 (&acc)[2][2][4][2], const Unit& u, int wr, int wc, int fr, int fq) const {
        const int row0 = u.pm * BM + wr * 64 + fr; const int col0 = u.pn * BM + wc * 32 + 4 * fq;
#pragma unroll
        for (int ai = 0; ai < 2; ++ai)
#pragma unroll
            for (int m = 0; m < 4; ++m) { float* rowp = O + (size_t)(row0 + ai * HALF + m * 16) * ldc + col0;
#pragma unroll
                for (int bj = 0; bj < 2; ++bj)
#pragma unroll
                    for (int n = 0; n < 2; ++n) *(f32x4*)(rowp + bj * HALF + n * 16) = acc[ai][bj][m][n]; }
    }
};

struct EpiB16 {
    static constexpr bool PERM = true, AFTER_DRAIN = false;
    bf16_t* O; int ldc;
    __device__ __forceinline__ void operator()(const f32x4 (&acc)[2][2][4][2], const Unit& u, int wr, int wc, int fr, int fq) const {
        const int row0 = u.pm * BM + wr * 64 + fr; const int col0 = u.pn * BM + wc * 32 + 8 * fq;
#pragma unroll
        for (int ai = 0; ai < 2; ++ai)
#pragma unroll
            for (int m = 0; m < 4; ++m) { bf16_t* rowp = O + (size_t)(row0 + ai * HALF + m * 16) * ldc + col0;
#pragma unroll
                for (int bj = 0; bj < 2; ++bj) *(u32x4*)(rowp + bj * HALF) = pack8(acc[ai][bj][m][0], acc[ai][bj][m][1]); }
    }
};

template <class Epi, class Sched, bool ALIGN_EPI = false, bool SP2 = false>
__device__ __forceinline__ void gemm_phase(PG8_LAS unsigned char* lds, const Gemm g, const Sched& S, const Epi& E) {
    const int tid = threadIdx.x, wid = __builtin_amdgcn_readfirstlane(tid >> 6), lane = tid & 63, wr = wid >> 2, wc = wid & 3, fr = lane & 15, fq = lane >> 4;
    const int K = g.K, nt = K / BK;
    unsigned voffA[2], voffB[2];
#pragma unroll
    for (int i = 0; i < 2; ++i) { int R, C; stage_rc(tid * 16 + i * 8192, R, C); const int Rb = Epi::PERM ? ((R & ~31) + perm32(R & 31)) : R;
        voffA[i] = (unsigned)(R * K + C) * 2u; voffB[i] = (unsigned)(Rb * K + C) * 2u; }
    const size_t kstep = (size_t)(BK * 2);
    const size_t hstep = (size_t)HALF * K * 2;
    const size_t tstep = 2 * hstep;
    const unsigned ldsw = (unsigned)wid * 1024u;
    const int aoff = lds_byte(wr * 64 + fr, fq * 8), boff = lds_byte(wc * 32 + fr, fq * 8);
#define PG8_SA(b, h) (((b) * 2 + (h)) * HTB)
#define PG8_SB(b, h) ((4 + (b) * 2 + (h)) * HTB)
#define PG8_STAGE(bufoff, gbase, voff) do { _Pragma("unroll") for (int _i = 0; _i < 2; ++_i) \
        __builtin_amdgcn_global_load_lds((const unsigned*)((const char*)(gbase) + (voff)[_i]), (PG8_LAS unsigned*)(lds + (bufoff) + ldsw + _i * 8192), 16, 0, 0); } while (0)
#define PG8_LDA(dst, b, h) do { _Pragma("unroll") for (int m = 0; m < 4; ++m) _Pragma("unroll") for (int k = 0; k < 2; ++k) dst[m][k] = *(const PG8_LAS bf16x8*)(lds + PG8_SA(b, h) + aoff + m * 2048 + k * 1024); } while (0)
#define PG8_LDB(dst, b, h) do { _Pragma("unroll") for (int n = 0; n < 2; ++n) _Pragma("unroll") for (int k = 0; k < 2; ++k) dst[n][k] = *(const PG8_LAS bf16x8*)(lds + PG8_SB(b, h) + boff + n * 2048 + k * 1024); } while (0)
#define PG8_MMA(ai, bj, At, Bt) do { __builtin_amdgcn_s_setprio(1); _Pragma("unroll") for (int m = 0; m < 4; ++m) _Pragma("unroll") for (int n = 0; n < 2; ++n) _Pragma("unroll") for (int k = 0; k < 2; ++k) \
        acc[ai][bj][m][n] = __builtin_amdgcn_mfma_f32_16x16x32_bf16(Bt[n][k], At[m][k], acc[ai][bj][m][n], 0, 0, 0); __builtin_amdgcn_s_setprio(0); } while (0)
#define PG8_WAIT_V(n) asm volatile("s_waitcnt vmcnt(" #n ")" ::: "memory")
#define PG8_WAIT_L(n) asm volatile("s_waitcnt lgkmcnt(" #n ")" ::: "memory")
#define PG8_BAR __builtin_amdgcn_s_barrier()
#define PG8_SCHED __builtin_amdgcn_sched_barrier(0)
    Unit cur, nxt; int ui = 0;
    if (!S.next(0, cur)) return;
    f32x4 acc[2][2][4][2];
#pragma unroll
    for (int a = 0; a < 2; ++a)
#pragma unroll
        for (int b = 0; b < 2; ++b)
#pragma unroll
            for (int m = 0; m < 4; ++m)
#pragma unroll
                for (int n = 0; n < 2; ++n) acc[a][b][m][n] = (f32x4){0.f, 0.f, 0.f, 0.f};
    bf16x8 At[4][2], B0[2][2], B1[2][2];
    const char* cA = (const char*)g.A + (size_t)cur.pm * tstep; const char* cB = (const char*)g.Bt + (size_t)cur.pn * tstep;
    S.a_ready(cur);
    if constexpr (SP2) {
        PG8_STAGE(PG8_SB(0, 0), cB, voffB); PG8_STAGE(PG8_SB(0, 1), cB + hstep, voffB); PG8_STAGE(PG8_SA(0, 0), cA, voffA); PG8_STAGE(PG8_SA(0, 1), cA + hstep, voffA);
        if (wr == 1) PG8_BAR;
        PG8_WAIT_V(2); PG8_BAR;
        PG8_STAGE(PG8_SB(1, 0), cB + kstep, voffB); PG8_STAGE(PG8_SA(1, 0), cA + kstep, voffA); PG8_STAGE(PG8_SB(1, 1), cB + hstep + kstep, voffB);
        PG8_WAIT_V(6); PG8_BAR;
    } else {
        PG8_STAGE(PG8_SB(0, 0), cB, voffB); PG8_STAGE(PG8_SA(0, 0), cA, voffA); PG8_STAGE(PG8_SB(0, 1), cB + hstep, voffB); PG8_STAGE(PG8_SA(0, 1), cA + hstep, voffA);
        if (wr == 1) PG8_BAR;
        PG8_WAIT_V(4); PG8_BAR;
        PG8_STAGE(PG8_SB(1, 0), cB + kstep, voffB); PG8_STAGE(PG8_SA(1, 0), cA + kstep, voffA); PG8_STAGE(PG8_SB(1, 1), cB + hstep + kstep, voffB);
        PG8_WAIT_V(6); PG8_BAR;
    }
    for (;;) {
        const bool has_next = S.next(ui + 1, nxt);
        const char* nA = has_next ? (const char*)g.A + (size_t)nxt.pm * tstep : cA; const char* nB = has_next ? (const char*)g.Bt + (size_t)nxt.pn * tstep : cB;
        for (int t = 0; t < nt; t += 2) {
            const bool last = (t == nt - 2);
            const char* a1 = cA + (size_t)(t + 1) * kstep;
            const char* a2 = last ? nA : cA + (size_t)(t + 2) * kstep; const char* b2 = last ? nB : cB + (size_t)(t + 2) * kstep;
            const char* a3 = a2 + kstep; const char* b3 = b2 + kstep;
            if (last && has_next) S.a_ready(nxt);
            if constexpr (SP2) {
            PG8_LDB(B0, 0, 0); PG8_LDB(B1, 0, 1); PG8_SCHED; PG8_LDA(At, 0, 0); PG8_STAGE(PG8_SA(1, 1), a1 + hstep, voffA);
            PG8_WAIT_V(8); PG8_WAIT_L(0); PG8_BAR; PG8_MMA(0, 0, At, B0); PG8_MMA(0, 1, At, B1); PG8_BAR; PG8_SCHED;
            PG8_LDA(At, 0, 1); PG8_STAGE(PG8_SB(0, 0), b2, voffB); PG8_STAGE(PG8_SB(0, 1), b2 + hstep, voffB); PG8_STAGE(PG8_SA(0, 0), a2, voffA);
            PG8_WAIT_V(8); PG8_WAIT_L(0); PG8_BAR; PG8_MMA(1, 0, At, B0); PG8_MMA(1, 1, At, B1); PG8_BAR; PG8_SCHED;
            PG8_LDB(B0, 1, 0); PG8_LDB(B1, 1, 1); PG8_SCHED; PG8_LDA(At, 1, 0); PG8_STAGE(PG8_SA(0, 1), a2 + hstep, voffA);
            PG8_WAIT_V(8); PG8_WAIT_L(0); PG8_BAR; PG8_MMA(0, 0, At, B0); PG8_MMA(0, 1, At, B1); PG8_BAR; PG8_SCHED;
            PG8_LDA(At, 1, 1); PG8_STAGE(PG8_SB(1, 0), b3, voffB); PG8_STAGE(PG8_SB(1, 1), b3 + hstep, voffB); PG8_STAGE(PG8_SA(1, 0), a3, voffA);
            PG8_WAIT_V(8); PG8_WAIT_L(0); PG8_BAR; PG8_MMA(1, 0, At, B0); PG8_MMA(1, 1, At, B1); PG8_BAR; PG8_SCHED;
            } else {
            PG8_LDB(B0, 0, 0); PG8_SCHED; PG8_LDA(At, 0, 0); PG8_STAGE(PG8_SA(1, 1), a1 + hstep, voffA);
            PG8_WAIT_L(8); PG8_BAR; PG8_WAIT_L(0); PG8_MMA(0, 0, At, B0); PG8_BAR; PG8_SCHED;
            PG8_LDB(B1, 0, 1); PG8_STAGE(PG8_SB(0, 0), b2, voffB);
            PG8_BAR; PG8_WAIT_L(0); PG8_MMA(0, 1, At, B1); PG8_BAR;
            PG8_LDA(At, 0, 1); PG8_STAGE(PG8_SA(0, 0), a2, voffA);
            PG8_BAR; PG8_WAIT_L(0); PG8_MMA(1, 0, At, B0); PG8_BAR; PG8_SCHED;
            PG8_STAGE(PG8_SB(0, 1), b2 + hstep, voffB);
            PG8_WAIT_V(6); PG8_BAR; PG8_MMA(1, 1, At, B1); PG8_BAR;
            PG8_LDB(B0, 1, 0); PG8_SCHED; PG8_LDA(At, 1, 0); PG8_STAGE(PG8_SA(0, 1), a2 + hstep, voffA);
            PG8_WAIT_L(8); PG8_BAR; PG8_WAIT_L(0); PG8_MMA(0, 0, At, B0); PG8_BAR; PG8_SCHED;
            PG8_LDB(B1, 1, 1); PG8_STAGE(PG8_SB(1, 0), b3, voffB);
            PG8_BAR; PG8_WAIT_L(0); PG8_MMA(0, 1, At, B1); PG8_BAR;
            PG8_LDA(At, 1, 1); PG8_STAGE(PG8_SA(1, 0), a3, voffA);
            PG8_BAR; PG8_WAIT_L(0); PG8_MMA(1, 0, At, B0); PG8_BAR; PG8_SCHED;
            PG8_STAGE(PG8_SB(1, 1), b3 + hstep, voffB);
            PG8_WAIT_V(6); PG8_BAR; PG8_MMA(1, 1, At, B1); PG8_BAR;
            }
        }
        if constexpr (ALIGN_EPI) { if (wr == 0) PG8_BAR; }
        if constexpr (!Epi::AFTER_DRAIN) { E(acc, cur, wr, wc, fr, fq); S.done(cur); }
        if (!has_next) break;
#pragma unroll
        for (int a = 0; a < 2; ++a)
#pragma unroll
            for (int b = 0; b < 2; ++b)
#pragma unroll
                for (int m = 0; m < 4; ++m)
#pragma unroll
                    for (int n = 0; n < 2; ++n) acc[a][b][m][n] = (f32x4){0.f, 0.f, 0.f, 0.f};
        cur = nxt; cA = nA; cB = nB; ++ui;
        if constexpr (ALIGN_EPI) { if (wr == 1) PG8_BAR; }
    }
    PG8_WAIT_V(0);
    if constexpr (!ALIGN_EPI) { if (wr == 0) PG8_BAR; }
    PG8_BAR;
    if constexpr (Epi::AFTER_DRAIN) { E.fused(acc, cur, wr, wc, fr, fq, lds, wid, lane); S.done(cur); }
#undef PG8_SA
#undef PG8_SB
#undef PG8_STAGE
#undef PG8_LDA
#undef PG8_LDB
#undef PG8_MMA
#undef PG8_WAIT_V
#undef PG8_WAIT_L
#undef PG8_BAR
#undef PG8_SCHED
}
}

#ifndef PG8_SP2
#define PG8_SP2 true
#endif
#ifndef PG8_ALIGN
#define PG8_ALIGN true
#endif
#include <hip/hip_bf16.h>
#include <cmath>
namespace attn_body {
using bf16=__hip_bfloat16;
using bf16x8=__attribute__((ext_vector_type(8)))short;
using s16x4=__attribute__((ext_vector_type(4)))short;
using f32x16=__attribute__((ext_vector_type(16)))float;
using u32x4=__attribute__((ext_vector_type(4)))unsigned;
using f32x4b=__attribute__((ext_vector_type(4)))float;
constexpr int BATCH=4,NHEAD=8,SEQ=4096,D=64,DM=NHEAD*D;
constexpr int NW=8,QBLK=32,QB=QBLK*NW,KVBLK=64,NQB=SEQ/QB;
constexpr int ATTN_PITCH=DM, ATTN_UNIT_ROWS=QB;
__device__ __forceinline__ int crow(int r,int hi){return (r&3)+8*(r>>2)+4*hi;}
#define SBAR() __builtin_amdgcn_sched_barrier(0)
__device__ __forceinline__ void cmask(f32x16&p0,f32x16&p1,int jb,int qrel,int hi){
  const float NEG=-INFINITY; int kb=64*jb+4*hi;
  #pragma unroll
  for(int r=0;r<16;++r){int kv=kb+(r&3)+8*(r>>2); if(kv>qrel)p0[r]=NEG; if(kv+32>qrel)p1[r]=NEG;}
}

constexpr int NSLOT=3, SLOTB=8192;
constexpr int LDS_K=0, LDS_V=NSLOT*SLOTB, LDS_WS=2*NSLOT*SLOTB, LDS_OST=LDS_WS+NW*64*4, LDS_BIAS=LDS_OST+NW*4096, LDS_BYTES=LDS_BIAS+SEQ*4;
constexpr float C2=0.125f*1.4426950408889634f;
__device__ __forceinline__ void glds16(const void*gsrc,unsigned lds_dst){unsigned keep;
  asm volatile("s_mov_b32 %0, m0\n\ts_mov_b32 m0, %2\n\ts_nop 0\n\tglobal_load_lds_dwordx4 %1, off\n\ts_mov_b32 m0, %0":"=&s"(keep):"v"(gsrc),"s"(lds_dst):"memory");}
__device__ __forceinline__ float max3f(float a,float b,float c){float r;asm("v_max3_f32 %0, %1, %2, %3":"=v"(r):"v"(a),"v"(b),"v"(c));return r;}
__device__ __forceinline__ float max2f(float a,float b){float r;asm("v_max_f32_e32 %0, %1, %2":"=v"(r):"v"(a),"v"(b));return r;}
__device__ __forceinline__ float fadd_s(float a,float b){float r;asm("v_add_f32_e32 %0, %1, %2":"=v"(r):"v"(a),"v"(b));return r;}
__device__ __forceinline__ float fsub_s(float a,float b){float r;asm("v_sub_f32_e32 %0, %1, %2":"=v"(r):"v"(a),"v"(b));return r;}
typedef float f32x2_t __attribute__((ext_vector_type(2))); typedef __bf16 bf16x2_t __attribute__((ext_vector_type(2)));
__device__ __forceinline__ unsigned cvtpk_s(float lo,float hi){f32x2_t v={lo,hi};bf16x2_t b=__builtin_convertvector(v,bf16x2_t);return __builtin_bit_cast(unsigned,b);}
#define WAIT_BAR(N) asm volatile("s_waitcnt vmcnt(" #N ") lgkmcnt(0)\n\ts_barrier":::"memory")

__device__ __forceinline__ void qkt(f32x16&p0,f32x16&p1,const char*Kslot,const bf16x8*qr,const f32x16&negm,int r32,int hi){
  const char*kb=Kslot+hi*1024+r32*16;
  #pragma unroll
  for(int d0=0;d0<4;++d0){
    const bf16x8 b0=*reinterpret_cast<const bf16x8*>(kb+d0*2048);
    const bf16x8 b1=*reinterpret_cast<const bf16x8*>(kb+d0*2048+512);
    if(d0==0){p0=__builtin_amdgcn_mfma_f32_32x32x16_bf16(b0,qr[0],negm,0,0,0);p1=__builtin_amdgcn_mfma_f32_32x32x16_bf16(b1,qr[0],negm,0,0,0);}
    else{p0=__builtin_amdgcn_mfma_f32_32x32x16_bf16(b0,qr[d0],p0,0,0,0);p1=__builtin_amdgcn_mfma_f32_32x32x16_bf16(b1,qr[d0],p1,0,0,0);}}
}
typedef __attribute__((address_space(3))) const char* lds_cptr;
typedef short v4i16_t __attribute__((ext_vector_type(4)));
__device__ __forceinline__ void kload8(bf16x8*kf,lds_cptr kp){
  kf[0]=*(const __attribute__((address_space(3))) bf16x8*)(kp);      kf[1]=*(const __attribute__((address_space(3))) bf16x8*)(kp+512);
  kf[2]=*(const __attribute__((address_space(3))) bf16x8*)(kp+2048); kf[3]=*(const __attribute__((address_space(3))) bf16x8*)(kp+2560);
  kf[4]=*(const __attribute__((address_space(3))) bf16x8*)(kp+4096); kf[5]=*(const __attribute__((address_space(3))) bf16x8*)(kp+4608);
  kf[6]=*(const __attribute__((address_space(3))) bf16x8*)(kp+6144); kf[7]=*(const __attribute__((address_space(3))) bf16x8*)(kp+6656);
}
__device__ __forceinline__ void kload2(bf16x8*kf,lds_cptr kp,int j){ kf[2*j]=*(const __attribute__((address_space(3))) bf16x8*)(kp+j*2048); kf[2*j+1]=*(const __attribute__((address_space(3))) bf16x8*)(kp+j*2048+512); }
__device__ __forceinline__ s16x4 vtr(lds_cptr p){ return __builtin_bit_cast(s16x4,__builtin_amdgcn_ds_read_tr16_b64_v4i16((__attribute__((address_space(3))) v4i16_t*)p)); }
__device__ __forceinline__ float rowmax(const f32x16&p0,const f32x16&p1){
  float a=max3f(p0[0],p0[1],p1[0]),b=max3f(p0[2],p0[3],p1[1]);a=max3f(a,p1[2],p1[3]);
  #pragma unroll
  for(int r=4;r<16;r+=4){a=max3f(a,p0[r],p0[r+1]);b=max3f(b,p0[r+2],p0[r+3]);a=max3f(a,p1[r],p1[r+1]);b=max3f(b,p1[r+2],p1[r+3]);}
  const float m=max2f(a,b);
  auto rr=__builtin_amdgcn_permlane32_swap(__float_as_uint(m),__float_as_uint(m),false,false);
  return max2f(__uint_as_float(rr[0]),__uint_as_float(rr[1]));
}
__device__ __forceinline__ void pv(f32x16*o,int vb,bf16x8 pa0,bf16x8 pa1,bf16x8 pa2,bf16x8 pa3){
  #pragma unroll
  for(int d0=0;d0<2;++d0){s16x4 lo[4],hi[4];
    #pragma unroll
    for(int ks=0;ks<4;++ks){
      asm volatile("ds_read_b64_tr_b16 %0,%1 offset:%c2":"=&v"(lo[ks]):"v"(vb),"i"(d0*4096+ks*1024):"memory");
      asm volatile("ds_read_b64_tr_b16 %0,%1 offset:%c2":"=&v"(hi[ks]):"v"(vb),"i"(d0*4096+ks*1024+512):"memory");}
    asm volatile("s_waitcnt lgkmcnt(0)":::"memory");SBAR();
    #define PK(k) (bf16x8){lo[k][0],lo[k][1],lo[k][2],lo[k][3],hi[k][0],hi[k][1],hi[k][2],hi[k][3]}
    o[d0]=__builtin_amdgcn_mfma_f32_32x32x16_bf16(pa0,PK(0),o[d0],0,0,0);
    o[d0]=__builtin_amdgcn_mfma_f32_32x32x16_bf16(pa1,PK(1),o[d0],0,0,0);
    o[d0]=__builtin_amdgcn_mfma_f32_32x32x16_bf16(pa2,PK(2),o[d0],0,0,0);
    o[d0]=__builtin_amdgcn_mfma_f32_32x32x16_bf16(pa3,PK(3),o[d0],0,0,0);
    #undef PK
  }
}

#ifndef ATTN_STORE16
#define ATTN_STORE16(p,v) (*(u32x4*)(p)=(v))
#endif
template<int THRL> __device__ __forceinline__ void attn_unit(int b,int h,int qb,int tskip,const bf16*Q,const bf16*__restrict__ K,const bf16*__restrict__ V,bf16*O,const float*FBh,char*shm){
  const int tid=threadIdx.x,lane=tid&63,r32=lane&31,hi=lane>>5; const int wid=__builtin_amdgcn_readfirstlane(tid>>6);
  const long rowbase=(long)b*SEQ; const int q0=qb*QB;
  const bf16*Qw=Q+(rowbase+q0+wid*QBLK)*DM+h*D;
  const int j0=tskip*KVBLK; const bf16*Kh=K+(rowbase+j0)*DM+h*D,*Vh=V+(rowbase+j0)*DM+h*D;
  const unsigned lds0=(unsigned)(uintptr_t)shm;
  float*wsf=(float*)(shm+LDS_WS)+wid*64;
  const bf16*ksrc=Kh+(long)lane*DM+wid*8;
  const bf16*vsrc=Vh+(long)(16*(wid&3)+(lane>>2))*DM+(wid>>2)*32+(lane&3)*8;
  const unsigned kdst=lds0+LDS_K+wid*1024, vdst=lds0+LDS_V+wid*1024;
  #define DMA_K(t,slot) glds16(ksrc+(long)(t)*KVBLK*DM,(unsigned)__builtin_amdgcn_readfirstlane(kdst+(slot)))
  #define DMA_V(t,slot) glds16(vsrc+(long)(t)*KVBLK*DM,(unsigned)__builtin_amdgcn_readfirstlane(vdst+(slot)))
  const int vb0=(int)(lds0+LDS_V)+((lane>>4)&1)*32+(lane&3)*8+(4*hi+((lane&15)>>2))*64;
  const char*Kbase=shm+LDS_K; bf16x8 kf[8];
  const lds_cptr shm3=(lds_cptr)shm; const lds_cptr kp0=shm3+LDS_K+hi*1024+r32*16; const lds_cptr vp0=shm3+LDS_V+((lane>>4)&1)*32+(lane&3)*8+(4*hi+((lane&15)>>2))*64;
  const int NT=(q0+QB)/KVBLK-tskip;
  int hib=hi; asm volatile("":"+v"(hib));
  const __attribute__((address_space(3))) float*biasp=(const __attribute__((address_space(3))) float*)((lds_cptr)shm+LDS_BIAS)+j0+4*hib;
  #define BIAS(P0,P1,t) do{ const __attribute__((address_space(3))) float*bp_=biasp+64*(t); \
    _Pragma("unroll") for(int k_=0;k_<4;++k_){ const f32x4b b0_=*(const __attribute__((address_space(3))) f32x4b*)(bp_+8*k_)-mhat; const f32x4b b1_=*(const __attribute__((address_space(3))) f32x4b*)(bp_+32+8*k_)-mhat; \
      P0[4*k_]+=b0_.x;P0[4*k_+1]+=b0_.y;P0[4*k_+2]+=b0_.z;P0[4*k_+3]+=b0_.w; P1[4*k_]+=b1_.x;P1[4*k_+1]+=b1_.y;P1[4*k_+2]+=b1_.z;P1[4*k_+3]+=b1_.w; } }while(0)
  #define PREB(P0,P1,t) do{ const __attribute__((address_space(3))) float*bp_=biasp+64*(t); \
    _Pragma("unroll") for(int k_=0;k_<4;++k_){ const f32x4b b0_=*(const __attribute__((address_space(3))) f32x4b*)(bp_+8*k_)-mhat; const f32x4b b1_=*(const __attribute__((address_space(3))) f32x4b*)(bp_+32+8*k_)-mhat; \
      P0[4*k_]=b0_.x;P0[4*k_+1]=b0_.y;P0[4*k_+2]=b0_.z;P0[4*k_+3]=b0_.w; P1[4*k_]=b1_.x;P1[4*k_+1]=b1_.y;P1[4*k_+2]=b1_.z;P1[4*k_+3]=b1_.w; } }while(0)
  DMA_K(0,0);DMA_V(0,0);DMA_K(1,SLOTB);
  bf16x8 qr[4];
  #pragma unroll
  for(int d0=0;d0<4;++d0)qr[d0]=*reinterpret_cast<const bf16x8*>(&Qw[(long)r32*DM+d0*16+hi*8]);
  float mhat=0.f,l_reg=0.f;f32x16 o[2];o[0]=f32x16{};o[1]=f32x16{};const f32x16 negm=f32x16{};
  const int qrel=wid*QBLK+r32;
  #define CMASK(P0,P1,t) do{int jb_=(t)-(NT-4); if(jb_>=0)cmask(P0,P1,jb_,qrel,hi);}while(0)
  bool resc=false;
  #define START(P0,P1) do{ const float rm=rowmax(P0,P1); resc=false; \
    { const float dl=rm; mhat=fadd_s(mhat,dl); \
      _Pragma("unroll") for(int r=0;r<16;++r){P0[r]=fsub_s(P0[r],dl);P1[r]=fsub_s(P1[r],dl);} \
      } \
    _Pragma("unroll") for(int r=0;r<16;++r)P0[r]=__builtin_amdgcn_exp2f(P0[r]); }while(0)
  #define RESC() do{ if(resc){ asm volatile("s_waitcnt lgkmcnt(0)":::"memory"); \
      _Pragma("unroll") for(int d_=0;d_<2;++d_) _Pragma("unroll") for(int r=0;r<16;++r)o[d_][r]*=wsf[crow(r,hi)]; } }while(0)
  f32x16 pA0,pA1,pB0,pB1;
  int sl_prev=0,sl_cur=0,sl_next=SLOTB;
  #define ROT() do{sl_prev=sl_cur;sl_cur=sl_next;sl_next=(sl_next==(NSLOT-1)*SLOTB)?0:sl_next+SLOTB;}while(0)
  DMA_K(2,2*SLOTB);
  WAIT_BAR(3);
  qkt(pA0,pA1,Kbase,qr,negm,r32,hi);asm volatile("s_nop 15\n\ts_nop 7":"+v"(pA0),"+v"(pA1));BIAS(pA0,pA1,0);CMASK(pA0,pA1,0);
  START(pA0,pA1);
  PREB(pB0,pB1,1);
  _Pragma("unroll") for(int r=0;r<16;++r)pA1[r]=__builtin_amdgcn_exp2f(pA1[r]);
  WAIT_BAR(0);
  DMA_K(3,0);DMA_V(1,SLOTB);
  ROT();
  kload8(kf,kp0+sl_cur);
  WAIT_BAR(2);
  s16x4 vlo[8],vhi[8]; u32x4 pw0,pw1,pw2,pw3;
  #define PKW(P,B) cvtpk_s(P[B],P[B+1])
  #define PAF(k) __builtin_bit_cast(bf16x8,pw##k)
  #define VFR(i) (bf16x8){vlo[i][0],vlo[i][1],vlo[i][2],vlo[i][3],vhi[i][0],vhi[i][1],vhi[i][2],vhi[i][3]}
  #define PIN(x) asm volatile("":"+v"(x))
  #define MX3(a,b,c) __builtin_fmaxf(__builtin_fmaxf((a),(b)),(c))
  #define GAPA(MF,A0,A1,A2,A3,W0,W1,PW) do{ MF; sacc+=A0; sacc+=A1; sacc+=A2; sacc+=A3; PIN(sacc); W0; W1; PIN(PW); SBAR(); }while(0)
  #define EX(v) __builtin_amdgcn_exp2f(v)
  #define GAPB(MF,X,B) do{ MF; X[B]=EX(X[B]); X[B+1]=EX(X[B+1]); X[B+2]=EX(X[B+2]); X[B+3]=EX(X[B+3]); PIN(X); SBAR(); }while(0)
  #define VRD(i) do{ vlo[i]=vtr(vp_+(((i)>>2)*4096+((i)&3)*1024)); vhi[i]=vtr(vp_+(((i)>>2)*4096+((i)&3)*1024+512)); }while(0)
  #define KRD(G,j) do{ if(G){ kload2(kf,kp0+sl_next,j); SBAR(); } }while(0)
  #define STEP(C0,C1,P0,P1,t,GK,GV,GL,GP) do{ SBAR(); \
    const lds_cptr vp_=vp0+sl_prev; \
    VRD(0); SBAR(); float sacc=(P0[0]+P0[1]); \
    GAPA(C0=__builtin_amdgcn_mfma_f32_32x32x16_bf16(kf[0],qr[0],C0,0,0,0), P0[2],P0[3],P0[4],P0[5],     pw0[0]=PKW(P0,0), pw0[1]=PKW(P0,2), pw0); \
    VRD(4); SBAR(); GAPA(C1=__builtin_amdgcn_mfma_f32_32x32x16_bf16(kf[1],qr[0],C1,0,0,0), P0[6],P0[7],P0[8],P0[9],     pw0[2]=PKW(P0,4), pw0[3]=PKW(P0,6), pw0); \
    VRD(1); SBAR(); GAPA(C0=__builtin_amdgcn_mfma_f32_32x32x16_bf16(kf[2],qr[1],C0,0,0,0),   P0[10],P0[11],P0[12],P0[13], pw1[0]=PKW(P0,8), pw1[1]=PKW(P0,10), pw1); \
    VRD(5); SBAR(); GAPA(C1=__builtin_amdgcn_mfma_f32_32x32x16_bf16(kf[3],qr[1],C1,0,0,0),   P0[14],P0[15],P1[0],P1[1],   pw1[2]=PKW(P0,12),pw1[3]=PKW(P0,14), pw1); \
    VRD(2); SBAR(); GAPA(C0=__builtin_amdgcn_mfma_f32_32x32x16_bf16(kf[4],qr[2],C0,0,0,0),   P1[2],P1[3],P1[4],P1[5],     pw2[0]=PKW(P1,0), pw2[1]=PKW(P1,2), pw2); \
    VRD(6); SBAR(); GAPA(C1=__builtin_amdgcn_mfma_f32_32x32x16_bf16(kf[5],qr[2],C1,0,0,0),   P1[6],P1[7],P1[8],P1[9],     pw2[2]=PKW(P1,4), pw2[3]=PKW(P1,6), pw2); \
    VRD(3); SBAR(); GAPA(C0=__builtin_amdgcn_mfma_f32_32x32x16_bf16(kf[6],qr[3],C0,0,0,0),   P1[10],P1[11],P1[12],P1[13], pw3[0]=PKW(P1,8), pw3[1]=PKW(P1,10), pw3); \
    VRD(7); SBAR(); GAPA(C1=__builtin_amdgcn_mfma_f32_32x32x16_bf16(kf[7],qr[3],C1,0,0,0),   P1[14],P1[15],0.f,0.f,       pw3[2]=PKW(P1,12),pw3[3]=PKW(P1,14), pw3); \
    l_reg+=sacc; \
    if(GK){DMA_K((t)+3,sl_cur);} if(GV){DMA_V((t)+1,sl_next);} \
    CMASK(C0,C1,t); \
    { float a=MX3(C0[0],C0[1],C1[0]),b=MX3(C0[2],C0[3],C1[1]); a=MX3(a,C1[2],C1[3]); \
      _Pragma("unroll") for(int r=4;r<16;r+=4){a=MX3(a,C0[r],C0[r+1]);b=MX3(b,C0[r+2],C0[r+3]);a=MX3(a,C1[r],C1[r+1]);b=MX3(b,C1[r+2],C1[r+3]);} \
      float rm=__builtin_fmaxf(a,b); { auto rr=__builtin_amdgcn_permlane32_swap(__float_as_uint(rm),__float_as_uint(rm),false,false); rm=__builtin_fmaxf(__uint_as_float(rr[0]),__uint_as_float(rr[1])); } \
      resc=false; \
      if(__builtin_expect(__any(rm>(float)THRL),0)){ const float dl=__builtin_fmaxf(rm,0.f); mhat+=dl; \
        _Pragma("unroll") for(int r=0;r<16;++r){C0[r]-=dl;C1[r]-=dl;} \
        const float f=__builtin_amdgcn_exp2f(-dl); l_reg*=f; if(hi==0)wsf[r32]=f; resc=true; } } \
    if(GP){PREB(P0,P1,(t)+1);} \
    SBAR(); \
    GAPB(o[0]=__builtin_amdgcn_mfma_f32_32x32x16_bf16(PAF(0),VFR(0),o[0],0,0,0), C0,0); \
    GAPB(o[1]=__builtin_amdgcn_mfma_f32_32x32x16_bf16(PAF(0),VFR(4),o[1],0,0,0), C0,4); \
    KRD(GL,0); GAPB(o[0]=__builtin_amdgcn_mfma_f32_32x32x16_bf16(PAF(1),VFR(1),o[0],0,0,0), C0,8); \
    KRD(GL,1); GAPB(o[1]=__builtin_amdgcn_mfma_f32_32x32x16_bf16(PAF(1),VFR(5),o[1],0,0,0), C0,12); \
    KRD(GL,2); GAPB(o[0]=__builtin_amdgcn_mfma_f32_32x32x16_bf16(PAF(2),VFR(2),o[0],0,0,0), C1,0); \
    KRD(GL,3); GAPB(o[1]=__builtin_amdgcn_mfma_f32_32x32x16_bf16(PAF(2),VFR(6),o[1],0,0,0), C1,4); \
    GAPB(o[0]=__builtin_amdgcn_mfma_f32_32x32x16_bf16(PAF(3),VFR(3),o[0],0,0,0), C1,8); \
    GAPB(o[1]=__builtin_amdgcn_mfma_f32_32x32x16_bf16(PAF(3),VFR(7),o[1],0,0,0), C1,12); \
    }while(0)
  int t=1;
  #undef CMASK
  #define CMASK(P0,P1,t) do{}while(0)
  for(;t+5<NT;t+=2){
    STEP(pB0,pB1,pA0,pA1,t,true,true,true,true);     WAIT_BAR(2); RESC(); ROT();
    STEP(pA0,pA1,pB0,pB1,t+1,true,true,true,true);   WAIT_BAR(2); RESC(); ROT();
  }
  #undef CMASK
  #define CMASK(P0,P1,t) do{int jb_=(t)-(NT-4); if(jb_>=0)cmask(P0,P1,jb_,qrel,hi);}while(0)
  #define ENDW(tt) do{ if((tt)+3<NT){WAIT_BAR(2);} else if((tt)+2<NT){WAIT_BAR(1);} else {WAIT_BAR(0);} }while(0)
  for(;t+1<NT;t+=2){
    STEP(pB0,pB1,pA0,pA1,t,(t+3<NT),(t+1<NT),(t+1<NT),(t+1<NT));       ENDW(t);   RESC(); ROT();
    STEP(pA0,pA1,pB0,pB1,t+1,(t+4<NT),(t+2<NT),(t+2<NT),(t+2<NT));     ENDW(t+1); RESC(); ROT();
  }
  STEP(pB0,pB1,pA0,pA1,NT-1,false,false,false,false); RESC();
  { float sacc=pB0[0]+pB0[1]; _Pragma("unroll") for(int r=2;r<16;++r)sacc+=pB0[r]; _Pragma("unroll") for(int r=0;r<16;++r)sacc+=pB1[r]; l_reg+=sacc;
    pw0=(u32x4){PKW(pB0,0),PKW(pB0,2),PKW(pB0,4),PKW(pB0,6)};pw1=(u32x4){PKW(pB0,8),PKW(pB0,10),PKW(pB0,12),PKW(pB0,14)};pw2=(u32x4){PKW(pB1,0),PKW(pB1,2),PKW(pB1,4),PKW(pB1,6)};pw3=(u32x4){PKW(pB1,8),PKW(pB1,10),PKW(pB1,12),PKW(pB1,14)};
    SBAR(); pv(o,vb0+sl_cur,PAF(0),PAF(1),PAF(2),PAF(3)); }
  #undef PKW
  #undef PAF
  #undef VFR
  #undef PIN
  #undef MX3
  #undef GAPA
  #undef GAPB
  #undef EX
  #undef VRD
  #undef KRD
  #undef STEP
  #undef ENDW
  {auto rr=__builtin_amdgcn_permlane32_swap(__float_as_uint(l_reg),__float_as_uint(l_reg),false,false);l_reg=__uint_as_float(rr[0])+__uint_as_float(rr[1]);}
  if(hi==0)wsf[32+r32]=l_reg;asm volatile("s_waitcnt lgkmcnt(0)":::"memory");
  float rli[16];
  #pragma unroll
  for(int r=0;r<16;++r)rli[r]=__builtin_amdgcn_rcpf(wsf[32+crow(r,hi)]);
  bf16*Ow=O+(rowbase+q0+wid*QBLK)*DM+h*D;
  { bf16*stg=(bf16*)(shm+LDS_OST)+wid*2048;
    #pragma unroll
    for(int r=0;r<16;++r){const int orow=crow(r,hi);
      #pragma unroll
      for(int d0=0;d0<2;++d0)stg[orow*64+d0*32+r32]=__float2bfloat16(o[d0][r]*rli[r]);}
    asm volatile("s_waitcnt lgkmcnt(0)":::"memory");
    #pragma unroll
    for(int i=0;i<4;++i){const int row=i*8+(lane>>3),ch=lane&7; const u32x4 v=*(const u32x4*)(stg+row*64+ch*8); ATTN_STORE16(Ow+(long)row*DM+ch*8,v);} }
  asm volatile("s_waitcnt lgkmcnt(0)\n\ts_barrier":::"memory");
  #undef BIAS
  #undef PREB
  #undef DMA_K
  #undef DMA_V
  #undef CMASK
  #undef START
  #undef RESC
  #undef ROT
}
constexpr int ATTN_LDS_BYTES=LDS_BYTES;
struct AttnTensors { const bf16* Q; const bf16* K; const bf16* V; bf16* O; const float* FB; };
struct AttnUnit { int bh; int qb; };
typedef __attribute__((address_space(3))) unsigned lds_u32;
__device__ __forceinline__ float sumsq8(const u32x4 w){ float s=0.f;
  #pragma unroll
  for(int e=0;e<4;++e){ const float lo=__uint_as_float(w[e]<<16), hi=__uint_as_float(w[e]&0xffff0000u); s+=lo*lo+hi*hi; } return s; }
template<int THRL=8> __device__ __forceinline__ void attn_phase(char*lds,const AttnTensors&T,unsigned*qctr,unsigned*km2,int vcu,int G){
  lds_u32*misc=(lds_u32*)((lds_cptr)lds+LDS_BYTES);
  const int tid=threadIdx.x;
  if(tid==0)misc[5]=0u;
  int k=vcu;
  for(;;){
    if(k>=BATCH*NHEAD*NQB)break;
    int bh,qb; if(k<256){bh=k>>3;qb=15-(k&7);}else{const int k2=k-256;qb=7-(k2>>5);bh=k2&31;}
    const int b=bh/NHEAD,h=bh%NHEAD,q0=qb*QB; const long rowbase=(long)b*SEQ; const float*FBh=T.FB+(long)bh*SEQ;
    __syncthreads();
    if(tid==0){misc[1]=0u; misc[2]=__float_as_uint(__uint_as_float(__hip_atomic_load(km2+2*bh,__ATOMIC_RELAXED,__HIP_MEMORY_SCOPE_AGENT))+__uint_as_float(__hip_atomic_load(km2+2*bh+1,__ATOMIC_RELAXED,__HIP_MEMORY_SCOPE_AGENT)));}
    __syncthreads();
    { const bf16*qp=T.Q+(rowbase+q0+(tid>>1))*DM+h*D+(tid&1)*32; float s=0.f;
      #pragma unroll
      for(int c=0;c<4;++c)s+=sumsq8(*(const u32x4*)(qp+8*c));
      s+=__shfl_xor(s,1);
      __hip_atomic_fetch_max(misc+1,__float_as_uint(s),__ATOMIC_RELAXED,__HIP_MEMORY_SCOPE_WORKGROUP); }
    __syncthreads();
    if(tid<64){ const float bound=2.0f*sqrtf(__uint_as_float(misc[1])*__uint_as_float(misc[2])); const float thr=FBh[q0]+bound+32.0f; const int NTf=4*qb+4;
      int tl=tid; asm volatile("":"+v"(tl));
      const bool keep=(tl>=NTf)||!(FBh[(tl<NTf?tl:0)*KVBLK+63]>=thr);
      const unsigned long long m=__ballot(keep); int ts=m?__ffsll((long long)m)-1:0; ts=(ts<NTf-4?ts:NTf-4)&~1; if(misc[5])ts=0;
      if(tid==0)misc[4]=(unsigned)ts; }
    { int tl=tid; asm volatile("":"+v"(tl));
      const f32x4b z4={0.f,0.f,0.f,0.f}; const float f0=FBh[q0]; const f32x4b fa=*(const f32x4b*)(FBh+4*tl); const f32x4b fb2=(q0+QB>2048)?*(const f32x4b*)(FBh+2048+4*tl):z4;
      __attribute__((address_space(3))) f32x4b*bl=(__attribute__((address_space(3))) f32x4b*)((lds_cptr)lds+LDS_BIAS);
      bl[tl]=f0-fa; if(q0+QB>2048)bl[512+tl]=f0-fb2; }
    __syncthreads();
    const int tskip=__builtin_amdgcn_readfirstlane((int)misc[4]);
    attn_unit<THRL>(b,h,qb,tskip,T.Q,T.K,T.V,T.O,FBh,lds);
    if(tid==0)misc[0]=(unsigned)G+__hip_atomic_fetch_add(qctr,1u,__ATOMIC_RELAXED,__HIP_MEMORY_SCOPE_AGENT);
    __syncthreads();
    k=__builtin_amdgcn_readfirstlane((int)misc[0]);
  }
}
#undef SBAR
#undef WAIT_BAR
}
#define GAS __attribute__((address_space(1)))
#define LAS __attribute__((address_space(3)))
typedef unsigned short bf16;
typedef unsigned v4u __attribute__((ext_vector_type(4)));
typedef float f32x4 __attribute__((ext_vector_type(4)));
typedef short bf16x8 __attribute__((ext_vector_type(8)));
typedef GAS unsigned gu32;
typedef GAS unsigned long long gu64;
#define RLX_AGENT __ATOMIC_RELAXED, __HIP_MEMORY_SCOPE_AGENT
#define LDS_WAIT() asm volatile("s_waitcnt lgkmcnt(0)" ::: "memory")
#define VM_WAIT() asm volatile("s_waitcnt vmcnt(0)" ::: "memory")
__device__ __forceinline__ unsigned long long rt() { return __builtin_amdgcn_s_memrealtime(); }
__device__ __forceinline__ unsigned f2bf(float f) { unsigned u = __builtin_bit_cast(unsigned, f); return (u + 0x7fffu + ((u >> 16) & 1u)) >> 16; }
__device__ __forceinline__ unsigned pk2(float lo, float hi) { return f2bf(lo) | (f2bf(hi) << 16); }

#define XB_TMO      128
#define XB_XCNT(j)  (256  + 64 * (j))
#define XB_XSUB(j)  (1280 + 64 * (j))
#define XB_XGEN(j)  (2304 + 64 * (j))
#define XB_TOP      3328
#define XB_TOPGEN   3392
#define XCD_BAR_WORDS 3456
#define XB_SPIN_CAP (1u << 18)

__device__ __forceinline__ unsigned xb_ld(unsigned* p)              { return __hip_atomic_load(p, __ATOMIC_RELAXED, __HIP_MEMORY_SCOPE_AGENT); }
__device__ __forceinline__ unsigned xb_add(unsigned* p, unsigned v) { return __hip_atomic_fetch_add(p, v, __ATOMIC_RELAXED, __HIP_MEMORY_SCOPE_AGENT); }
__device__ __forceinline__ unsigned xb_xcc_id() { return (unsigned)__builtin_amdgcn_s_getreg((3 << 11) | 20) & 0xFu; }
#define XB_SPIN(cond, bar) do { unsigned _sp = 0; while (cond) { __builtin_amdgcn_s_sleep(1); \
    if ((++_sp & 255u) == 0u) { if (xb_ld(&(bar)[XB_TMO])) break; if (_sp > XB_SPIN_CAP) { atomicAdd(&(bar)[XB_TMO], 1u); break; } } } } while (0)

struct XcdBarrier {
    unsigned* bar; unsigned x;
    volatile LAS unsigned* st;
};

__device__ __forceinline__ XcdBarrier xcd_barrier_post(unsigned* bar, volatile LAS unsigned* st) {
    XcdBarrier b; b.bar = bar; b.x = xb_xcc_id(); b.st = st;
    if (threadIdx.x == 0) (void)xb_add(&bar[XB_XCNT(b.x)], 1u);
    return b;
}
__device__ __forceinline__ void xcd_barrier_complete(unsigned* bar, unsigned x, unsigned& nloc, unsigned& nx) {
    const unsigned G = gridDim.x * gridDim.y * gridDim.z;
    unsigned sum, cnt, mine, sp = 0u;
    for (;;) {
        sum = 0u; cnt = 0u; mine = 0u;
#pragma unroll
        for (unsigned j = 0; j < 16; ++j) { const unsigned c = xb_ld(&bar[XB_XCNT(j)]); sum += c; cnt += (c > 0u) ? 1u : 0u; mine = (j == x) ? c : mine; }
        if (sum == G) break;
        __builtin_amdgcn_s_sleep(1);
        if ((++sp & 255u) == 0u) { if (xb_ld(&bar[XB_TMO])) break; if (sp > XB_SPIN_CAP) { atomicAdd(&bar[XB_TMO], 1u); break; } }
    }
    nloc = mine > 0u ? mine : 1u; nx = cnt > 0u ? cnt : 1u;
}

__device__ __forceinline__ void xcd_barrier(const XcdBarrier& b) {
    asm volatile("s_waitcnt vmcnt(0)" ::: "memory");
    __syncthreads();
    if (threadIdx.x == 0) {
        unsigned* bar = b.bar;
        __builtin_amdgcn_s_waitcnt(0);
        unsigned nloc = b.st[0], nx = b.st[1];
        if (nloc == 0u) { xcd_barrier_complete(bar, b.x, nloc, nx); b.st[0] = nloc; b.st[1] = nx; }
        const unsigned old = xb_add(&bar[XB_XSUB(b.x)], 1u);
        const unsigned gen = old / nloc;
        if (old + 1u == (gen + 1u) * nloc) {
            __builtin_amdgcn_fence(__ATOMIC_RELEASE, "agent");
            asm volatile("s_waitcnt vmcnt(0)" ::: "memory");
            const unsigned og = xb_add(&bar[XB_TOP], 1u);
            const unsigned tg = og / nx;
            if (og + 1u == (tg + 1u) * nx) xb_add(&bar[XB_TOPGEN], 1u);
            else XB_SPIN(xb_ld(&bar[XB_TOPGEN]) == tg, bar);
            __builtin_amdgcn_fence(__ATOMIC_ACQUIRE, "agent");
            xb_add(&bar[XB_XGEN(b.x)], 1u);
            asm volatile("s_waitcnt vmcnt(0)" ::: "memory");
        } else {
            XB_SPIN(xb_ld(&bar[XB_XGEN(b.x)]) == gen, bar);
            __builtin_amdgcn_fence(__ATOMIC_ACQUIRE, "agent");
            asm volatile("s_waitcnt vmcnt(0)" ::: "memory");
        }
    }
    __syncthreads();
}

constexpr int NWAVES = 8, NTHR = NWAVES * 64;
constexpr int BATCH = 4, SEQ = 4096, D = 1024, M = BATCH * SEQ, NH = 8, HD = 64, AW = 512, CC = 512, CK = 31;
constexpr int WIN_LD = 4616, NIN = 4608;
constexpr int OFF_F = 1536, OFF_CA = 1544, OFF_CB = 2056, OFF_GA = 2568, OFF_GB = 3592;
constexpr int PH = 8, NKEYS = 128, PDH = 64, TOPK = 16, NSEL = PH * TOPK;
constexpr float LN_EPS = 1e-5f, ALPHA = 1.189207115002721f, LOG2E = 1.4426950408889634f;
constexpr float QSCALE = 0.125f * LOG2E;
constexpr int MODW = 6 * D;

constexpr size_t MiB = 1u << 20;
constexpr size_t WS_CTL = 0, CTL_ZERO_BYTES = 65536;
constexpr size_t WS_PART = 1 * MiB;
constexpr size_t WS_LOGF = 1 * MiB + 512 * 1024;
constexpr size_t WS_FB = 2 * MiB;
constexpr size_t WS_WIN = 4 * MiB, WS_WA = 13 * MiB, WS_WB = 14 * MiB, WS_WO = 15 * MiB, WS_WQ = 17 * MiB;
constexpr size_t WS_R1 = 20 * MiB;
constexpr size_t WS_Q = 52 * MiB, WS_K = 68 * MiB, WS_V = 84 * MiB, WS_G = 100 * MiB, WS_HC = 116 * MiB;
constexpr size_t WS_SGA = 132 * MiB, WS_SGB = 164 * MiB;
constexpr size_t WS_OUTF = 132 * MiB;
constexpr size_t WS_QP = 52 * MiB;
constexpr size_t WS_IDX = 116 * MiB, WS_GATE = 124 * MiB;
constexpr size_t WS_SU = 3 * MiB, WS_SV = 3 * MiB + 65536, WS_SX = 3 * MiB + 131072;
constexpr size_t WS_W8 = 244 * MiB;
constexpr size_t WS_U8 = 196 * MiB, WS_V8 = 212 * MiB;
constexpr size_t WS_X8 = 228 * MiB;
constexpr size_t WS_AO = 228 * MiB;
constexpr size_t WS_APART = 132 * MiB;
constexpr size_t WS_YP = 52 * MiB;
constexpr size_t WS_END = 247 * MiB;
constexpr int W8P = 144;
constexpr int NEXP = 16384;
constexpr int CW_TMO = 0, CW_CODE = 1, CW_BAR = 4096, CW_RANK = 8192, CW_AQ = 10240;

constexpr int RING_OFF = 0, RING_BYTES = 131072;
constexpr int LDSCTL_OFF = RING_BYTES, MISC_OFF = LDSCTL_OFF + 320;
constexpr int LDS_BYTES = 147456;

template <int CTRL> __device__ __forceinline__ float dppf(float v) { return __uint_as_float((unsigned)__builtin_amdgcn_update_dpp(0, (int)__float_as_uint(v), CTRL, 0xF, 0xF, true)); }
template <int CTRL> __device__ __forceinline__ int dppi(int v) { return __builtin_amdgcn_update_dpp(0, v, CTRL, 0xF, 0xF, true); }
__device__ __forceinline__ float wave_sum(float v) {
    v += dppf<0xB1>(v); v += dppf<0x4E>(v); v += dppf<0x141>(v); v += dppf<0x140>(v);
    { const auto r = __builtin_amdgcn_permlane16_swap(__float_as_uint(v), __float_as_uint(v), false, false); v = __uint_as_float(r[0]) + __uint_as_float(r[1]); }
    { const auto r = __builtin_amdgcn_permlane32_swap(__float_as_uint(v), __float_as_uint(v), false, false); v = __uint_as_float(r[0]) + __uint_as_float(r[1]); }
    return v;
}
__device__ __forceinline__ float wave_max(float v) {
    v = fmaxf(v, dppf<0xB1>(v)); v = fmaxf(v, dppf<0x4E>(v)); v = fmaxf(v, dppf<0x141>(v)); v = fmaxf(v, dppf<0x140>(v));
    { const auto r = __builtin_amdgcn_permlane16_swap(__float_as_uint(v), __float_as_uint(v), false, false); v = fmaxf(__uint_as_float(r[0]), __uint_as_float(r[1])); }
    { const auto r = __builtin_amdgcn_permlane32_swap(__float_as_uint(v), __float_as_uint(v), false, false); v = fmaxf(__uint_as_float(r[0]), __uint_as_float(r[1])); }
    return v;
}
__device__ __forceinline__ int xlane16(int v, int lane) { const auto r = __builtin_amdgcn_permlane16_swap((unsigned)v, (unsigned)v, false, false); return (lane & 16) ? (int)r[0] : (int)r[1]; }
__device__ __forceinline__ int xlane32(int v, int lane) { const auto r = __builtin_amdgcn_permlane32_swap((unsigned)v, (unsigned)v, false, false); return (lane & 32) ? (int)r[0] : (int)r[1]; }
__device__ __forceinline__ float bf_lo(unsigned w) { return __uint_as_float(w << 16); }
__device__ __forceinline__ float bf_hi(unsigned w) { return __uint_as_float(w & 0xffff0000u); }

__device__ __forceinline__ void p0_transpose_item(const float* W, int ldw, int src_col0, bf16* WT, int K, int dst_row0, int k0, LAS float* scr, int lane) {
#pragma unroll
    for (int i = 0; i < 32; ++i) { const int kk = 2 * i + (lane >> 5); scr[kk * 33 + (lane & 31)] = W[(size_t)(k0 + kk) * ldw + src_col0 + (lane & 31)]; }
    LDS_WAIT(); asm volatile("" ::: "memory");
    const int c = lane & 7;
#pragma unroll
    for (int j = 0; j < 4; ++j) { const int n = (lane >> 3) + 8 * j; const LAS float* s = scr + (8 * c) * 33 + n;
        v4u o; o.x = pk2(s[0 * 33], s[1 * 33]); o.y = pk2(s[2 * 33], s[3 * 33]); o.z = pk2(s[4 * 33], s[5 * 33]); o.w = pk2(s[6 * 33], s[7 * 33]);
        *(GAS v4u*)(WT + (size_t)(dst_row0 + n) * K + k0 + 8 * c) = o; }
    LDS_WAIT(); asm volatile("" ::: "memory");
}
__device__ __forceinline__ int win_src_col(int r) {
    if (r < 1536) return r;
    if (r < 2560) { const int rr = r - 1536, t = rr >> 8, w = rr & 255; return w < 128 ? OFF_CA + 128 * t + w : OFF_CB + 128 * t + (w - 128); }
    if (r < 3584) return OFF_GA + (r - 2560);
    return OFF_GB + (r - 3584);
}
__device__ __forceinline__ void p0_prologue(LAS unsigned char* lds, const float* const* in, unsigned char* ws, int tid, int lane, int wave, int G) {
    LAS float* sl = (LAS float*)(lds + 98304);
#pragma unroll
    for (int it = 0; it < BATCH * D / NTHR; ++it) { const int i = tid + it * NTHR; const float c = in[1][i]; sl[i] = c / (1.0f + __expf(-c)); }
    __syncthreads();
    LAS float* scr = (LAS float*)(lds + wave * 12288);
    const int gw = (int)blockIdx.x * NWAVES + wave, NGW = G * NWAVES;
    constexpr int I_MOD = 192 * 4, I_WIN = 16 * (NIN / 32), I_WA = 8 * 32, I_WB = 8 * 32, I_WO = 16 * 32, I_WQ = 16 * 32;
    constexpr int NITEMS = I_MOD + I_WIN + I_WA + I_WB + I_WO + I_WQ;
    const float* w_mod = in[2]; const float* b_mod = in[3];
    float* part = (float*)(ws + WS_PART);
    for (int it = gw; it < NITEMS; it += NGW) {
        int r = it;
        if (r < I_MOD) {
            const int chunk = r % 192, kq = r / 192, kk = lane >> 3, cq = lane & 7, col = chunk * 32 + cq * 4;
            f32x4 acc[4];
#pragma unroll
            for (int b = 0; b < 4; ++b) acc[b] = (f32x4){0.f, 0.f, 0.f, 0.f};
#pragma unroll
            for (int i = 0; i < 32; ++i) { const int k = kq * 256 + i * 8 + kk; const f32x4 w = *(const GAS f32x4*)(w_mod + (size_t)k * MODW + col);
#pragma unroll
                for (int b = 0; b < 4; ++b) acc[b] += w * sl[b * D + k]; }
#pragma unroll
            for (int b = 0; b < 4; ++b)
#pragma unroll
                for (int j = 0; j < 4; ++j) { float v = acc[b][j]; v += __shfl_xor(v, 8); v += __shfl_xor(v, 16); v += __shfl_xor(v, 32); acc[b][j] = v; }
            if (kk == 0) {
                f32x4 bias = (f32x4){0.f, 0.f, 0.f, 0.f}; if (kq == 0) bias = *(const GAS f32x4*)(b_mod + col);
#pragma unroll
                for (int b = 0; b < 4; ++b) *(GAS f32x4*)(part + (size_t)(kq * 4 + b) * MODW + col) = acc[b] + bias;
            }
            continue;
        }
        r -= I_MOD;
        const float* W; int ldw, scol, K, drow, k0; size_t dsto;
        if (r < I_WIN) { const int kb = r / (NIN / 32), db = r % (NIN / 32); W = in[4]; ldw = WIN_LD; scol = win_src_col(32 * db); K = D; drow = 32 * db; k0 = 64 * kb; dsto = WS_WIN; }
        else { r -= I_WIN; ldw = D; scol = 32 * (r % 32); drow = scol;
            if (r < I_WA) { W = in[10]; K = AW; dsto = WS_WA; }
            else if ((r -= I_WA) < I_WB) { W = in[11]; K = CC; dsto = WS_WB; }
            else if ((r -= I_WB) < I_WO) { W = in[12]; K = D; dsto = WS_WO; }
            else { r -= I_WO; W = in[15]; K = D; dsto = WS_WQ; }
            scol = 32 * (r % 32); drow = scol; k0 = 64 * (r / 32); }
        p0_transpose_item(W, ldw, scol, (bf16*)(ws + dsto), K, drow, k0, scr, lane);
    }
}
constexpr int TC_TICKETS = 2 * NEXP / 32;
__device__ __forceinline__ void tc_tables(const float* const* in, unsigned char* ws, int ticket, int lane, int wave) {
    { const int row0 = 32 * ticket + 4 * wave;
        f32x4 v[4][4];
#pragma unroll
        for (int r = 0; r < 4; ++r) { const int row = row0 + r; const bool isv = row >= NEXP; const int e = isv ? row - NEXP : row;
            const GAS f32x4* src = (const GAS f32x4*)((isv ? in[18] : in[17]) + (size_t)e * D) + lane;
#pragma unroll
            for (int j = 0; j < 4; ++j) v[r][j] = __builtin_nontemporal_load(src + 64 * j); }
#pragma unroll
        for (int r = 0; r < 4; ++r) { const int row = row0 + r; const bool isv = row >= NEXP; const int e = isv ? row - NEXP : row;
            float am = 0.f;
#pragma unroll
            for (int j = 0; j < 4; ++j) am = fmaxf(am, fmaxf(fmaxf(fabsf(v[r][j].x), fabsf(v[r][j].y)), fmaxf(fabsf(v[r][j].z), fabsf(v[r][j].w))));
            am = wave_max(am);
            const float inv = am > 0.f ? 127.0f / am : 0.f;
            GAS unsigned* dst = (GAS unsigned*)(ws + (isv ? WS_V8 : WS_U8) + (size_t)e * D) + lane;
#pragma unroll
            for (int j = 0; j < 4; ++j) { const int q0 = (int)rintf(v[r][j].x * inv), q1 = (int)rintf(v[r][j].y * inv), q2 = (int)rintf(v[r][j].z * inv), q3 = (int)rintf(v[r][j].w * inv);
                dst[64 * j] = (unsigned)(q0 & 255) | ((unsigned)(q1 & 255) << 8) | ((unsigned)(q2 & 255) << 16) | ((unsigned)(q3 & 255) << 24); }
            if (lane == 0) ((float*)(ws + (isv ? WS_SV : WS_SU)))[e] = am * (1.0f / 127.0f); }
    }
}
template <int NCOLS> __device__ __forceinline__ void load_mod(LAS float* dst, const float* part, int col0, int tid) {
    constexpr int NIT = BATCH * NCOLS / NTHR; static_assert(BATCH * NCOLS % NTHR == 0, "load_mod");
    float v[NIT][4];
#pragma unroll
    for (int j = 0; j < NIT; ++j) { const int i = tid + j * NTHR, b = i / NCOLS, c = i % NCOLS;
#pragma unroll
        for (int kq = 0; kq < 4; ++kq) v[j][kq] = part[(size_t)(kq * 4 + b) * MODW + col0 + c]; }
#pragma unroll
    for (int j = 0; j < NIT; ++j) dst[tid + j * NTHR] = (v[j][0] + v[j][1]) + (v[j][2] + v[j][3]);
}

__device__ __forceinline__ void p1_ln_pass(LAS unsigned char* lds, const float* const* in, unsigned char* ws, int tid, int lane, int wave, int G) {
    LAS float* modL = (LAS float*)lds;
    LAS float* wfL = (LAS float*)(lds + 32768);
    const float* part = (const float*)(ws + WS_PART);
    load_mod<2048>(modL, part, 0, tid);
#pragma unroll
    for (int it_ = 0; it_ < D * 2 / NTHR; ++it_) { const int i = tid + it_ * NTHR; const int d = i >> 1, hf = i & 1; const f32x4 w4 = *(const GAS f32x4*)(in[4] + (size_t)d * WIN_LD + OFF_F + hf * 4);
        wfL[(hf * 4 + 0) * D + d] = w4.x; wfL[(hf * 4 + 1) * D + d] = w4.y; wfL[(hf * 4 + 2) * D + d] = w4.z; wfL[(hf * 4 + 3) * D + d] = w4.w; }
    __syncthreads();
    const float* x = in[0]; const float* b_f = in[5];
    bf16* U = (bf16*)(ws + WS_R1); float* logf = (float*)(ws + WS_LOGF);
    const int gw = (int)blockIdx.x * NWAVES + wave, NGW = G * NWAVES;
    f32x4 nx[4];
    if (gw < M) {
#pragma unroll
        for (int j = 0; j < 4; ++j) nx[j] = ((const GAS f32x4*)(x + (size_t)gw * D) + lane)[64 * j]; }
    for (int m = gw; m < M; m += NGW) {
        const int b = m / SEQ;
        f32x4 v[4]; float s = 0.f;
#pragma unroll
        for (int j = 0; j < 4; ++j) { v[j] = nx[j]; s += (v[j].x + v[j].y) + (v[j].z + v[j].w); }
        { const int mn = (m + NGW < M) ? m + NGW : m; const GAS f32x4* xr = (const GAS f32x4*)(x + (size_t)mn * D) + lane;
#pragma unroll
          for (int j = 0; j < 4; ++j) nx[j] = xr[64 * j]; }
        const float mean = wave_sum(s) * (1.f / D); float s2 = 0.f;
#pragma unroll
        for (int j = 0; j < 4; ++j) { v[j] = v[j] - mean; s2 += (v[j].x * v[j].x + v[j].y * v[j].y) + (v[j].z * v[j].z + v[j].w * v[j].w); }
        const float rstd = 1.f / sqrtf(wave_sum(s2) * (1.f / D) + LN_EPS);
        float f[8];
#pragma unroll
        for (int h = 0; h < 8; ++h) f[h] = 0.f;
        GAS unsigned long long* o8 = (GAS unsigned long long*)(U + (size_t)m * D) + lane;
#pragma unroll
        for (int j = 0; j < 4; ++j) { const int d0 = 256 * j + 4 * lane;
            const f32x4 sh = *(const LAS f32x4*)(modL + b * 2048 + d0), sc = *(const LAS f32x4*)(modL + b * 2048 + 1024 + d0);
            f32x4 u = v[j] * rstd * (sc + 1.0f) + sh;
            o8[64 * j] = (unsigned long long)pk2(u.x, u.y) | ((unsigned long long)pk2(u.z, u.w) << 32);
#pragma unroll
            for (int h = 0; h < 8; ++h) { const f32x4 w4 = *(const LAS f32x4*)(wfL + h * D + d0); f[h] += (u.x * w4.x + u.y * w4.y) + (u.z * w4.z + u.w * w4.w); } }
#pragma unroll
        for (int h = 0; h < 8; ++h) f[h] = wave_sum(f[h]);
        float fz = f[0];
#pragma unroll
        for (int h = 1; h < 8; ++h) fz = (lane == h) ? f[h] : fz;
        if (lane < 8) { const float z = fz + b_f[lane]; logf[(size_t)m * 8 + lane] = fminf(z, 0.f) - log1pf(expf(-fabsf(z))); }
    }
}

__device__ __forceinline__ void p2_scan(LAS unsigned char* lds, unsigned char* ws, int bh, int tid, int lane, int wave) {
    LAS float* tot = (LAS float*)lds;
    const float* logf = (const float*)(ws + WS_LOGF); float* FB = (float*)(ws + WS_FB);
    const int b = bh >> 3, h = bh & 7;
    float v[8]; float run = 0.f;
#pragma unroll
    for (int k = 0; k < 8; ++k) { run += logf[((size_t)b * SEQ + 8 * tid + k) * 8 + h]; v[k] = run; }
    float inc = run;
#pragma unroll
    for (int o = 1; o < 64; o <<= 1) { const float t = __shfl_up(inc, o); if (lane >= o) inc += t; }
    if (lane == 63) tot[wave] = inc;
    __syncthreads();
    float base = inc - run;
    for (int w = 0; w < wave; ++w) base += tot[w];
#pragma unroll
    for (int k = 0; k < 8; ++k) FB[(size_t)bh * SEQ + 8 * tid + k] = (base + v[k]) * LOG2E;
    __syncthreads();
}

__device__ __forceinline__ void p3_conv_unit(LAS unsigned char* lds, const float* const* in, unsigned char* ws, int unit, int tid, int lane, int wave) {
    LAS bf16* gt = (LAS bf16*)lds; LAS float* ct = (LAS float*)(lds + 63488);
    const bf16* Gm = (const bf16*)(ws + WS_G); bf16* HC = (bf16*)(ws + WS_HC);
    const int m0 = unit * 32, s0 = m0 % SEQ;
    __syncthreads();
    { v4u w[8];
#pragma unroll
      for (int it = 0; it < 8; ++it) { const int i = tid + it * NTHR, r = i >> 6, c8 = i & 63; w[it] = (v4u){0u, 0u, 0u, 0u};
          if (i < 62 * 64 && (r >= 30 || s0 != 0)) w[it] = *(const GAS v4u*)(Gm + (size_t)(m0 - 30 + r) * CC + 8 * c8); }
#pragma unroll
      for (int it = 0; it < 8; ++it) { const int i = tid + it * NTHR, r = i >> 6, c8 = i & 63; if (i < 62 * 64) *(LAS v4u*)(gt + r * 512 + 8 * c8) = w[it]; } }
    float w[CK];
#pragma unroll
    for (int k = 0; k < CK; ++k) w[k] = in[6][k * CC + tid];
    const float cb = in[7][tid];
    __syncthreads();
#pragma unroll 1
    for (int g8 = 0; g8 < 4; ++g8) {
        float acc[8];
#pragma unroll
        for (int t = 0; t < 8; ++t) acc[t] = cb;
#pragma unroll
        for (int r = 0; r < 38; ++r) { const float gv = __uint_as_float((unsigned)gt[(g8 * 8 + r) * 512 + tid] << 16);
#pragma unroll
            for (int t = 0; t < 8; ++t) { const int k = r - t; if (k >= 0 && k < CK) acc[t] += w[k] * gv; } }
#pragma unroll
        for (int t = 0; t < 8; ++t) ct[(g8 * 8 + t) * 512 + tid] = acc[t];
    }
    __syncthreads();
    const float* lg = in[8]; const float* lb = in[9];
    const f32x4 g0 = *(const GAS f32x4*)(lg + 8 * lane), g1 = *(const GAS f32x4*)(lg + 8 * lane + 4), b0 = *(const GAS f32x4*)(lb + 8 * lane), b1 = *(const GAS f32x4*)(lb + 8 * lane + 4);
#pragma unroll 1
    for (int t = 0; t < 4; ++t) { const int tok = wave * 4 + t;
        const f32x4 a0 = *(const LAS f32x4*)(ct + tok * 512 + 8 * lane), a1 = *(const LAS f32x4*)(ct + tok * 512 + 8 * lane + 4);
        const float mean = wave_sum((a0.x + a0.y) + (a0.z + a0.w) + (a1.x + a1.y) + (a1.z + a1.w)) * (1.f / CC);
        const f32x4 d0 = a0 - mean, d1 = a1 - mean;
        const float var = wave_sum((d0.x * d0.x + d0.y * d0.y) + (d0.z * d0.z + d0.w * d0.w) + (d1.x * d1.x + d1.y * d1.y) + (d1.z * d1.z + d1.w * d1.w)) * (1.f / CC);
        const float rstd = 1.f / sqrtf(var + LN_EPS);
        f32x4 y0 = d0 * rstd * g0 + b0, y1 = d1 * rstd * g1 + b1;
#pragma unroll
        for (int e = 0; e < 4; ++e) { y0[e] = y0[e] / (1.0f + __expf(-y0[e])); y1[e] = y1[e] / (1.0f + __expf(-y1[e])); }
        v4u o; o.x = pk2(y0.x, y0.y); o.y = pk2(y0.z, y0.w); o.z = pk2(y1.x, y1.y); o.w = pk2(y1.z, y1.w);
        *(GAS v4u*)(HC + (size_t)(m0 + tok) * CC + 8 * lane) = o; }
}

__device__ __forceinline__ void p6_ln_pass(LAS unsigned char* lds, const float* const* in, float* out, unsigned char* ws, int tid, int lane, int wave, int G) {
    LAS float* modL = (LAS float*)lds;
    load_mod<3072>(modL, (const float*)(ws + WS_PART), 2048, tid);
    __syncthreads();
    const float* x = in[0]; const bf16* outf = (const bf16*)(ws + WS_OUTF); const float* lg = in[13]; const float* lb = in[14];
    bf16* U2 = (bf16*)(ws + WS_R1);
    const int gw = (int)blockIdx.x * NWAVES + wave, NGW = G * NWAVES;
    f32x4 nx[4]; unsigned long long no[4];
    if (gw < M) {
#pragma unroll
        for (int j = 0; j < 4; ++j) { nx[j] = ((const GAS f32x4*)(x + (size_t)gw * D) + lane)[64 * j]; no[j] = ((const GAS unsigned long long*)(outf + (size_t)gw * D) + lane)[64 * j]; } }
    for (int m = gw; m < M; m += NGW) {
        const int b = m / SEQ;
        f32x4 v[4]; float s = 0.f;
#pragma unroll
        for (int j = 0; j < 4; ++j) { const f32x4 g1 = *(const LAS f32x4*)(modL + b * 3072 + 256 * j + 4 * lane);
            const unsigned long long ow = no[j]; const unsigned olo = (unsigned)ow, ohi = (unsigned)(ow >> 32); const f32x4 ov = (f32x4){bf_lo(olo), bf_hi(olo), bf_lo(ohi), bf_hi(ohi)};
            v[j] = nx[j] * ALPHA + (g1 + 1.0f) * ov; s += (v[j].x + v[j].y) + (v[j].z + v[j].w); }
        { const int mn = (m + NGW < M) ? m + NGW : m; const GAS f32x4* xr = (const GAS f32x4*)(x + (size_t)mn * D) + lane; const GAS unsigned long long* orr = (const GAS unsigned long long*)(outf + (size_t)mn * D) + lane;
#pragma unroll
          for (int j = 0; j < 4; ++j) { nx[j] = xr[64 * j]; no[j] = orr[64 * j]; } }
        float mean = wave_sum(s) * (1.f / D); float s2 = 0.f;
#pragma unroll
        for (int j = 0; j < 4; ++j) { v[j] = v[j] - mean; s2 += (v[j].x * v[j].x + v[j].y * v[j].y) + (v[j].z * v[j].z + v[j].w * v[j].w); }
        float rstd = 1.f / sqrtf(wave_sum(s2) * (1.f / D) + LN_EPS);
        s = 0.f;
        GAS f32x4* x1r = (GAS f32x4*)(out + (size_t)m * D) + lane;
#pragma unroll
        for (int j = 0; j < 4; ++j) { const f32x4 gg = *(const GAS f32x4*)(lg + 256 * j + 4 * lane), bb = *(const GAS f32x4*)(lb + 256 * j + 4 * lane);
            v[j] = v[j] * rstd * gg + bb; x1r[64 * j] = v[j]; s += (v[j].x + v[j].y) + (v[j].z + v[j].w); }
        mean = wave_sum(s) * (1.f / D); s2 = 0.f;
#pragma unroll
        for (int j = 0; j < 4; ++j) { v[j] = v[j] - mean; s2 += (v[j].x * v[j].x + v[j].y * v[j].y) + (v[j].z * v[j].z + v[j].w * v[j].w); }
        rstd = 1.f / sqrtf(wave_sum(s2) * (1.f / D) + LN_EPS);
        GAS unsigned long long* o8 = (GAS unsigned long long*)(U2 + (size_t)m * D) + lane; float am = 0.f;
#pragma unroll
        for (int j = 0; j < 4; ++j) { const f32x4 sh = *(const LAS f32x4*)(modL + b * 3072 + 1024 + 256 * j + 4 * lane), sc = *(const LAS f32x4*)(modL + b * 3072 + 2048 + 256 * j + 4 * lane);
            const f32x4 u = v[j] * rstd * (sc + 1.0f) + sh; v[j] = u;
            am = fmaxf(am, fmaxf(fmaxf(fabsf(u.x), fabsf(u.y)), fmaxf(fabsf(u.z), fabsf(u.w))));
            o8[64 * j] = (unsigned long long)pk2(u.x, u.y) | ((unsigned long long)pk2(u.z, u.w) << 32); }
        am = wave_max(am);
        const float inv = am > 0.f ? 127.0f / am : 0.f;
        GAS unsigned* x8 = (GAS unsigned*)(ws + WS_X8 + (size_t)m * D) + lane;
#pragma unroll
        for (int j = 0; j < 4; ++j) { const int q0 = (int)rintf(v[j].x * inv), q1 = (int)rintf(v[j].y * inv), q2 = (int)rintf(v[j].z * inv), q3 = (int)rintf(v[j].w * inv);
            x8[64 * j] = (unsigned)(q0 & 255) | ((unsigned)(q1 & 255) << 8) | ((unsigned)(q2 & 255) << 16) | ((unsigned)(q3 & 255) << 24); }
        if (lane == 0) ((float*)(ws + WS_SX))[m] = am * (1.0f / 127.0f);
    }
}

#define CE_D(a, b) do { const float hi_ = fmaxf((a), (b)), lo_ = fminf((a), (b)); (a) = hi_; (b) = lo_; } while (0)
template <int OFF> __device__ __forceinline__ void sort16_desc(float (&v)[64]) {
    constexpr int NET[63][2] = {{0,1},{2,3},{0,2},{1,3},{1,2},{4,5},{6,7},{4,6},{5,7},{5,6},{0,4},{2,6},{2,4},{1,5},{3,7},{3,5},{1,2},{3,4},{5,6},{8,9},{10,11},{8,10},{9,11},{9,10},{12,13},{14,15},{12,14},{13,15},{13,14},{8,12},{10,14},{10,12},{9,13},{11,15},{11,13},{9,10},{11,12},{13,14},{0,8},{4,12},{4,8},{2,10},{6,14},{6,10},{2,4},{6,8},{10,12},{1,9},{5,13},{5,9},{3,11},{7,15},{7,11},{3,5},{7,9},{11,13},{1,2},{3,4},{5,6},{7,8},{9,10},{11,12},{13,14}};
#pragma unroll
    for (int i = 0; i < 63; ++i) CE_D(v[OFF + NET[i][0]], v[OFF + NET[i][1]]);
}
__device__ __forceinline__ void merge16_desc(float (&a)[16]) {
#pragma unroll
    for (int j = 8; j > 0; j >>= 1)
#pragma unroll
        for (int i = 0; i < 16; ++i) { const int l = i ^ j; if (l > i) CE_D(a[i], a[l]); }
}
__device__ __forceinline__ void mergetrunc16(float (&a)[16], const float (&b)[16]) {
#pragma unroll
    for (int i = 0; i < 16; ++i) a[i] = fmaxf(a[i], b[15 - i]);
    merge16_desc(a);
}
__device__ __forceinline__ float tagf(float x, unsigned mask, unsigned tag) { return __uint_as_float((__float_as_uint(x) & ~mask) | tag); }
typedef float f32x16_t __attribute__((ext_vector_type(16)));
constexpr int KROW = 72;
constexpr int P8_KH = 0, P8_KL = 2 * NKEYS * KROW * 2, P8_IDX = 2 * P8_KL;
__device__ __forceinline__ bf16x8 split_hi8(const f32x4& a, const f32x4& b, f32x4& ra, f32x4& rb) {
    bf16x8 o;
#pragma unroll
    for (int e = 0; e < 4; ++e) { const unsigned ha = f2bf(a[e]), hb = f2bf(b[e]); o[e] = (short)ha; o[4 + e] = (short)hb; ra[e] = a[e] - __uint_as_float(ha << 16); rb[e] = b[e] - __uint_as_float(hb << 16); }
    return o;
}
template <class Sched> __device__ __forceinline__ void p8_topk(LAS unsigned char* lds, const float* const* in, unsigned char* ws, int tid, int lane, int wave, const Sched& S) {
#pragma unroll
    for (int it_ = 0; it_ < 2 * NKEYS * PDH / 4 / NTHR; ++it_) { const int i = tid + it_ * NTHR; const f32x4 k4 = *(const GAS f32x4*)(in[16] + 4 * i); const int row = i >> 4, c4 = (i & 15) * 4;
        unsigned h[4], l[4];
#pragma unroll
        for (int e = 0; e < 4; ++e) { h[e] = f2bf(k4[e]); l[e] = f2bf(k4[e] - __uint_as_float(h[e] << 16)); }
        *(LAS unsigned long long*)(lds + P8_KH + (row * KROW + c4) * 2) = (unsigned long long)(h[0] | (h[1] << 16)) | ((unsigned long long)(h[2] | (h[3] << 16)) << 32);
        *(LAS unsigned long long*)(lds + P8_KL + (row * KROW + c4) * 2) = (unsigned long long)(l[0] | (l[1] << 16)) | ((unsigned long long)(l[2] | (l[3] << 16)) << 32); }
    __syncthreads();
    const float* QP = (const float*)(ws + WS_QP); unsigned short* IDX = (unsigned short*)(ws + WS_IDX); float* GATE = (float*)(ws + WS_GATE);
    const int j = lane & 31, hi = lane >> 5;
    LAS unsigned char* ib = lds + P8_IDX + wave * 2048 + lane;
    pg8::Unit un;
#pragma unroll 1
    for (int ui = 0; S.next(ui, un); ++ui) {
        const int t0 = un.pm * 256 + 32 * wave, hp = un.pn;
        float L0[16], sv0[16], sv1[16];
#pragma unroll
        for (int i = 0; i < 16; ++i) { L0[i] = 0.f; sv0[i] = 0.f; sv1[i] = 0.f; }
#pragma unroll 1
        for (int inst = 0; inst < 4; ++inst) {
            const int hh = inst >> 1, p = inst & 1;
            bf16x8 qh[4], ql[4];
            { const float* qrow = QP + (size_t)(t0 + j) * D + (2 * hp + hh) * 128 + p * 64 + 8 * hi;
#pragma unroll
              for (int ks = 0; ks < 4; ++ks) { const f32x4 a = *(const GAS f32x4*)(qrow + 16 * ks), b = *(const GAS f32x4*)(qrow + 16 * ks + 4); f32x4 ra, rb, r2a, r2b;
                  qh[ks] = split_hi8(a, b, ra, rb); ql[ks] = split_hi8(ra, rb, r2a, r2b); } }
            f32x16_t acc[4];
            const int koff = ((p * NKEYS + j) * KROW + 8 * hi) * 2;
#pragma unroll
            for (int kb = 0; kb < 4; ++kb) {
                acc[kb] = (f32x16_t){0.f, 0.f, 0.f, 0.f, 0.f, 0.f, 0.f, 0.f, 0.f, 0.f, 0.f, 0.f, 0.f, 0.f, 0.f, 0.f};
#pragma unroll
                for (int ks = 0; ks < 4; ++ks) { const int off = koff + (32 * kb * KROW + 16 * ks) * 2;
                    const bf16x8 kh = *(const LAS bf16x8*)(lds + P8_KH + off), kl = *(const LAS bf16x8*)(lds + P8_KL + off);
                    acc[kb] = __builtin_amdgcn_mfma_f32_32x32x16_bf16(kh, qh[ks], acc[kb], 0, 0, 0);
                    acc[kb] = __builtin_amdgcn_mfma_f32_32x32x16_bf16(kh, ql[ks], acc[kb], 0, 0, 0);
                    acc[kb] = __builtin_amdgcn_mfma_f32_32x32x16_bf16(kl, qh[ks], acc[kb], 0, 0, 0); }
            }
            float v[64];
#pragma unroll
            for (int kb = 0; kb < 4; ++kb)
#pragma unroll
                for (int r = 0; r < 16; ++r) v[16 * kb + r] = tagf(acc[kb][r], 127u, 127u - (unsigned)(32 * kb + (r & 3) + 8 * (r >> 2)));
            sort16_desc<0>(v); sort16_desc<16>(v); sort16_desc<32>(v); sort16_desc<48>(v);
            float a0[16], a1[16], a2[16], a3[16];
#pragma unroll
            for (int i = 0; i < 16; ++i) { a0[i] = v[i]; a1[i] = v[16 + i]; a2[i] = v[32 + i]; a3[i] = v[48 + i]; }
            mergetrunc16(a0, a1); mergetrunc16(a2, a3); mergetrunc16(a0, a2);
#pragma unroll
            for (int i = 0; i < 16; ++i) a0[i] = __uint_as_float(__float_as_uint(a0[i]) & ~((unsigned)hi << 2));
            if (p == 0) {
#pragma unroll
                for (int i = 0; i < 16; ++i) L0[i] = a0[i];
            } else {
                float X[16], Y[16];
#pragma unroll
                for (int i = 0; i < 16; ++i) { const auto rr = __builtin_amdgcn_permlane32_swap(__float_as_uint(L0[i]), __float_as_uint(a0[i]), false, false); X[i] = __uint_as_float(rr[0]); Y[i] = __uint_as_float(rr[1]); }
                mergetrunc16(X, Y);
#pragma unroll
                for (int i = 0; i < 16; ++i) { const auto rr = __builtin_amdgcn_permlane32_swap(__float_as_uint(X[i]), __float_as_uint(X[i]), false, false);
                    sv0[i] = (hi == hh) ? __uint_as_float(rr[0]) : sv0[i]; sv1[i] = (hi == hh) ? __uint_as_float(rr[1]) : sv1[i]; }
            }
        }
        const int head = 2 * hp + hi;
#pragma unroll
        for (int i = 0; i < 16; ++i) { ib[i * 64] = (unsigned char)(127u - (__float_as_uint(sv0[i]) & 127u)); ib[(16 + i) * 64] = (unsigned char)(127u - (__float_as_uint(sv1[i]) & 127u)); }
#define CAND(a, b) tagf(sv0[a] + sv1[b], 255u, 255u - (unsigned)((a) * 16 + (b)))
        float T[16], U1[16];
#pragma unroll
        for (int b = 0; b < 16; ++b) T[b] = CAND(0, b);
#pragma unroll
        for (int b = 0; b < 8; ++b) { U1[b] = CAND(1, b); U1[8 + b] = CAND(15 - b, 0); }
        merge16_desc(U1);
        mergetrunc16(T, U1);
#pragma unroll
        for (int a = 2; a < 8; ++a)
#pragma unroll
            for (int b = 0; b < 16; ++b) if ((a + 1) * (b + 1) <= 16) { float x = CAND(a, b);
#pragma unroll
                for (int i = (a + 1) * (b + 1) - 1; i < 16; ++i) CE_D(T[i], x); }
#undef CAND
        float e[16]; float sum = 0.f;
#pragma unroll
        for (int i = 0; i < 16; ++i) { e[i] = __expf(T[i] - T[0]); sum += e[i]; }
        const float rs = 1.0f / sum;
        LDS_WAIT(); asm volatile("" ::: "memory");
        int ce[16];
#pragma unroll
        for (int i = 0; i < 16; ++i) { const unsigned id = 255u - (__float_as_uint(T[i]) & 255u); ce[i] = (int)ib[(id >> 4) * 64] * NKEYS + (int)ib[(16 + (id & 15u)) * 64]; }
        const size_t o = (size_t)(t0 + j) * NSEL + head * 16;
#pragma unroll
        for (int i = 0; i < 16; i += 8) *(GAS v4u*)(IDX + o + i) = (v4u){(unsigned)ce[i] | ((unsigned)ce[i + 1] << 16), (unsigned)ce[i + 2] | ((unsigned)ce[i + 3] << 16), (unsigned)ce[i + 4] | ((unsigned)ce[i + 5] << 16), (unsigned)ce[i + 6] | ((unsigned)ce[i + 7] << 16)};
#pragma unroll
        for (int i = 0; i < 16; i += 4) {
            *(GAS f32x4*)(GATE + o + i) = (f32x4){e[i] * rs, e[i + 1] * rs, e[i + 2] * rs, e[i + 3] * rs}; }
        LDS_WAIT(); asm volatile("" ::: "memory");
    }
}

typedef int v4i __attribute__((ext_vector_type(4)));
__device__ __forceinline__ float gelu_tanh(float a) { const float y = 0.7978845608028654f * (a + 0.044715f * a * a * a); const float t = 1.0f - 2.0f / (1.0f + __expf(2.0f * y)); return 0.5f * a * (1.0f + t); }
struct G1Item { v4i row[16]; v4i x; };
struct GMeta { unsigned mi; v4i mv; };
__device__ __forceinline__ void g_meta_load(const unsigned* IDXd, const unsigned char* side, int side_pitch, int nside, int t, int lane, GMeta& m) {
    m.mi = IDXd[(size_t)t * (NSEL / 2) + lane];
    if (lane < nside) m.mv = *(const GAS v4i*)(side + (size_t)t * side_pitch + 16 * lane);
}
__device__ __forceinline__ void g_meta_lds(LAS unsigned char* wl, const GMeta& m, int nside, int lane, int rr, int (&e)[16]) {
    ((LAS unsigned*)wl)[lane] = m.mi;
    if (lane < nside) *(LAS v4i*)(wl + 256 + 16 * lane) = m.mv;
    asm volatile("s_waitcnt lgkmcnt(0)" ::: "memory");
#pragma unroll
    for (int q = 0; q < 2; ++q) { const v4u ev = *(const LAS v4u*)(wl + 32 * rr + 16 * q);
#pragma unroll
        for (int j = 0; j < 4; ++j) { e[8 * q + 2 * j] = (int)(ev[j] & 0xffffu); e[8 * q + 2 * j + 1] = (int)(ev[j] >> 16); } }
}
__device__ __forceinline__ void g1_rows(const unsigned char* U8, const int (&e)[16], G1Item& it) {
#pragma unroll
    for (int i = 0; i < 16; ++i) it.row[i] = *(const GAS v4i*)(U8 + (size_t)e[i] * D);
}
__device__ __forceinline__ void g1_compute(const G1Item& it, int* AP, int t, int rr, int c) {
    int p[16];
#pragma unroll
    for (int i = 0; i < 16; ++i) { int a = __builtin_amdgcn_sdot4(it.row[i].x, it.x.x, 0, false); a = __builtin_amdgcn_sdot4(it.row[i].y, it.x.y, a, false); a = __builtin_amdgcn_sdot4(it.row[i].z, it.x.z, a, false); p[i] = __builtin_amdgcn_sdot4(it.row[i].w, it.x.w, a, false); }
    int q8[8], q4[4], q2[2];
    { const bool up = (c >> 2) & 1;
#pragma unroll
      for (int j = 0; j < 8; ++j) { const int keep = up ? p[8 + j] : p[j], send = up ? p[j] : p[8 + j]; q8[j] = keep + dppi<0x141>(send); } }
    { const bool up = c & 1;
#pragma unroll
      for (int j = 0; j < 4; ++j) { const int keep = up ? q8[4 + j] : q8[j], send = up ? q8[j] : q8[4 + j]; q4[j] = keep + dppi<0xB1>(send); } }
    { const bool up = (c >> 1) & 1;
#pragma unroll
      for (int j = 0; j < 2; ++j) { const int keep = up ? q4[2 + j] : q4[j], send = up ? q4[j] : q4[2 + j]; q2[j] = keep + dppi<0x4E>(send); } }
    const int i0 = 8 * ((c >> 2) & 1) + 4 * (c & 1) + 2 * ((c >> 1) & 1);
    typedef int v2i __attribute__((ext_vector_type(2)));
    *(GAS v2i*)(AP + (size_t)t * NSEL + 16 * rr + i0) = (v2i){q2[0], q2[1]};
}
__device__ __forceinline__ void p9_g1(LAS unsigned char* lds, unsigned char* ws, int lane, int wave, int sl, int tb, int ntb) {
    const int rr = lane >> 3, c = lane & 7;
    const unsigned* IDXd = (const unsigned*)(ws + WS_IDX); const unsigned char* U8 = ws + WS_U8 + 128 * sl + 16 * c; const unsigned char* X8s = ws + WS_X8 + 128 * sl;
    int* AP = (int*)(ws + WS_APART) + (size_t)sl * M * NSEL;
    LAS unsigned char* wl = lds + wave * 512;
    const int tstep = ntb * NWAVES, tfirst = tb * NWAVES + wave;
    if (tfirst >= M) return;
#define TCL(t) ((t) < M ? (t) : tfirst)
    G1Item A, B; GMeta mA, mB; int e[16];
    g_meta_load(IDXd, X8s, D, 8, tfirst, lane, mA); g_meta_lds(wl, mA, 8, lane, rr, e); A.x = *(const LAS v4i*)(wl + 256 + 16 * c); g1_rows(U8, e, A);
    g_meta_load(IDXd, X8s, D, 8, TCL(tfirst + tstep), lane, mB);
#pragma unroll 1
    for (int t = tfirst; t < M; t += 2 * tstep) {
        g_meta_load(IDXd, X8s, D, 8, TCL(t + 2 * tstep), lane, mA); g_meta_lds(wl, mB, 8, lane, rr, e); B.x = *(const LAS v4i*)(wl + 256 + 16 * c); g1_rows(U8, e, B);
        g1_compute(A, AP, t, rr, c);
        g_meta_load(IDXd, X8s, D, 8, TCL(t + 3 * tstep), lane, mB); g_meta_lds(wl, mA, 8, lane, rr, e); A.x = *(const LAS v4i*)(wl + 256 + 16 * c); g1_rows(U8, e, A);
        if (t + tstep < M) g1_compute(B, AP, t + tstep, rr, c);
    }
#undef TCL
}
__device__ __forceinline__ void p10_w(unsigned char* ws, int lane, int wave, int G) {
    const unsigned short* IDX = (const unsigned short*)(ws + WS_IDX); const float* GATE = (const float*)(ws + WS_GATE); const int* AP = (const int*)(ws + WS_APART);
    const float* SU = (const float*)(ws + WS_SU); const float* SV = (const float*)(ws + WS_SV); const float* SX = (const float*)(ws + WS_SX);
    unsigned char* W8 = ws + WS_W8;
    const int gw = (int)blockIdx.x * NWAVES + wave, NGW = G * NWAVES;
    if (gw >= M) return;
    typedef int v2i_t __attribute__((ext_vector_type(2))); typedef float v2f_t __attribute__((ext_vector_type(2)));
    unsigned ep; v2i_t ap[8]; v2f_t gt; float sx;
#define W_LOAD1(t) do { ep = ((const unsigned*)IDX)[(size_t)(t) * (NSEL / 2) + lane]; gt = *(const GAS v2f_t*)(GATE + (size_t)(t) * NSEL + 2 * lane); sx = SX[t]; \
        _Pragma("unroll") for (int s = 0; s < 8; ++s) ap[s] = *(const GAS v2i_t*)(AP + ((size_t)s * M + (t)) * NSEL + 2 * lane); } while (0)
    W_LOAD1(gw);
    for (int t = gw; t < M; t += NGW) {
        const int e0 = (int)(ep & 0xffffu), e1 = (int)(ep >> 16);
        const float su0 = SU[e0], su1 = SU[e1], sv0 = SV[e0], sv1 = SV[e1];
        int s0 = 0, s1 = 0;
#pragma unroll
        for (int s = 0; s < 8; ++s) { s0 += ap[s].x; s1 += ap[s].y; }
        const float a0 = (float)s0 * sx * su0, a1 = (float)s1 * sx * su1, gg0 = gt.x, gg1 = gt.y;
        { const int tn = (t + NGW < M) ? t + NGW : t; W_LOAD1(tn); }
        const float w0 = gelu_tanh(a0) * gg0 * sv0, w1 = gelu_tanh(a1) * gg1 * sv1;
        float am = wave_max(fmaxf(fabsf(w0), fabsf(w1)));
        const float inv = am > 0.f ? 127.0f / am : 0.f;
        *(GAS unsigned short*)(W8 + (size_t)t * W8P + 2 * lane) = (unsigned short)(((unsigned)((int)rintf(w0 * inv) & 255)) | (((unsigned)((int)rintf(w1 * inv) & 255)) << 8));
        if (lane == 0) *(float*)(W8 + (size_t)t * W8P + NSEL) = am * (1.0f / 127.0f);
    }
#undef W_LOAD1
}
struct G2Item { v4u row[16]; v4i w8; float wsc; };
__device__ __forceinline__ void g2_rows(const unsigned char* V8, const int (&e)[16], G2Item& it) {
#pragma unroll
    for (int i = 0; i < 16; ++i) it.row[i] = *(const GAS v4u*)(V8 + (size_t)e[i] * D);
}
__device__ __forceinline__ void g2_compute(const G2Item& it, bf16* YP, int t, int sl, int rr, int c, int lane) {
    int acc[16];
#pragma unroll
    for (int i = 0; i < 16; ++i) acc[i] = 0;
#pragma unroll
    for (int g = 0; g < 4; ++g)
#pragma unroll
        for (int q = 0; q < 4; ++q) { const unsigned r0 = it.row[4 * g][q], r1 = it.row[4 * g + 1][q], r2 = it.row[4 * g + 2][q], r3 = it.row[4 * g + 3][q];
            const unsigned a = __builtin_amdgcn_perm(r1, r0, 0x05010400u), b = __builtin_amdgcn_perm(r1, r0, 0x07030602u), cc = __builtin_amdgcn_perm(r3, r2, 0x05010400u), d = __builtin_amdgcn_perm(r3, r2, 0x07030602u);
            const unsigned c0 = __builtin_amdgcn_perm(cc, a, 0x05040100u), c1 = __builtin_amdgcn_perm(cc, a, 0x07060302u), c2 = __builtin_amdgcn_perm(d, b, 0x05040100u), c3 = __builtin_amdgcn_perm(d, b, 0x07060302u);
            const int w4 = it.w8[g];
            acc[4 * q] = __builtin_amdgcn_sdot4((int)c0, w4, acc[4 * q], false); acc[4 * q + 1] = __builtin_amdgcn_sdot4((int)c1, w4, acc[4 * q + 1], false);
            acc[4 * q + 2] = __builtin_amdgcn_sdot4((int)c2, w4, acc[4 * q + 2], false); acc[4 * q + 3] = __builtin_amdgcn_sdot4((int)c3, w4, acc[4 * q + 3], false); }
    int q8[8], q4[4], q2[2];
    { const bool up = rr & 1;
#pragma unroll
      for (int j = 0; j < 8; ++j) { const int keep = up ? acc[8 + j] : acc[j], send = up ? acc[j] : acc[8 + j]; q8[j] = keep + dppi<0x128>(send); } }
    { const bool up = (rr >> 1) & 1;
#pragma unroll
      for (int j = 0; j < 4; ++j) { const int keep = up ? q8[4 + j] : q8[j], send = up ? q8[j] : q8[4 + j]; q4[j] = keep + xlane16(send, lane); } }
    { const bool up = (rr >> 2) & 1;
#pragma unroll
      for (int j = 0; j < 2; ++j) { const int keep = up ? q4[2 + j] : q4[j], send = up ? q4[j] : q4[2 + j]; q2[j] = keep + xlane32(send, lane); } }
    const int i0 = 8 * (rr & 1) + 4 * ((rr >> 1) & 1) + 2 * ((rr >> 2) & 1);
    *(GAS unsigned*)(YP + (size_t)t * D + 128 * sl + 16 * c + i0) = pk2((float)q2[0] * it.wsc, (float)q2[1] * it.wsc);
}
__device__ __forceinline__ void p11_g2(LAS unsigned char* lds, unsigned char* ws, int lane, int wave, int sl, int tb, int ntb) {
    const int rr = lane >> 3, c = lane & 7;
    const unsigned* IDXd = (const unsigned*)(ws + WS_IDX); const unsigned char* W8 = ws + WS_W8;
    const unsigned char* V8 = ws + WS_V8 + 128 * sl + 16 * c; bf16* YP = (bf16*)(ws + WS_YP);
    LAS unsigned char* wl = lds + wave * 512;
    const int tstep = ntb * NWAVES, tfirst = tb * NWAVES + wave;
    if (tfirst >= M) return;
#define TCL(t) ((t) < M ? (t) : tfirst)
#define G2_SIDE(IT) do { IT.w8 = *(const LAS v4i*)(wl + 256 + 16 * rr); IT.wsc = *(const LAS float*)(wl + 256 + NSEL); } while (0)
    G2Item A, B; GMeta mA, mB; int e[16];
    g_meta_load(IDXd, W8, W8P, 9, tfirst, lane, mA); g_meta_lds(wl, mA, 9, lane, rr, e); G2_SIDE(A); g2_rows(V8, e, A);
    g_meta_load(IDXd, W8, W8P, 9, TCL(tfirst + tstep), lane, mB);
#pragma unroll 1
    for (int t = tfirst; t < M; t += 2 * tstep) {
        g_meta_load(IDXd, W8, W8P, 9, TCL(t + 2 * tstep), lane, mA); g_meta_lds(wl, mB, 9, lane, rr, e); G2_SIDE(B); g2_rows(V8, e, B);
        g2_compute(A, YP, t, sl, rr, c, lane);
        g_meta_load(IDXd, W8, W8P, 9, TCL(t + 3 * tstep), lane, mB); g_meta_lds(wl, mA, 9, lane, rr, e); G2_SIDE(A); g2_rows(V8, e, A);
        if (t + tstep < M) g2_compute(B, YP, t + tstep, sl, rr, c, lane);
    }
#undef G2_SIDE
#undef TCL
}
__device__ __forceinline__ void p12_final(LAS unsigned char* lds, const float* const* in, float* out, unsigned char* ws, int tid, int lane, int wave, int G) {
    LAS float* g2L = (LAS float*)lds;
    load_mod<1024>(g2L, (const float*)(ws + WS_PART), 5120, tid);
    __syncthreads();
    const bf16* YP = (const bf16*)(ws + WS_YP); const float* lg = in[19]; const float* lb = in[20];
    const int gw = (int)blockIdx.x * NWAVES + wave, NGW = G * NWAVES;
    f32x4 nx[4]; unsigned long long ny[4];
    if (gw < M) {
#pragma unroll
        for (int j = 0; j < 4; ++j) { nx[j] = ((const GAS f32x4*)(out + (size_t)gw * D) + lane)[64 * j]; ny[j] = ((const GAS unsigned long long*)(YP + (size_t)gw * D) + lane)[64 * j]; } }
    for (int m = gw; m < M; m += NGW) {
        const int b = m / SEQ;
        GAS f32x4* xr = (GAS f32x4*)(out + (size_t)m * D) + lane; f32x4 v[4]; float s = 0.f;
#pragma unroll
        for (int j = 0; j < 4; ++j) { const f32x4 g2 = *(const LAS f32x4*)(g2L + b * 1024 + 256 * j + 4 * lane); const unsigned long long yw = ny[j]; const unsigned ylo = (unsigned)yw, yhi = (unsigned)(yw >> 32);
            v[j] = nx[j] * ALPHA + (g2 + 1.0f) * (f32x4){bf_lo(ylo), bf_hi(ylo), bf_lo(yhi), bf_hi(yhi)}; s += (v[j].x + v[j].y) + (v[j].z + v[j].w); }
        { const int mn = (m + NGW < M) ? m + NGW : m; const GAS f32x4* xn = (const GAS f32x4*)(out + (size_t)mn * D) + lane; const GAS unsigned long long* yr = (const GAS unsigned long long*)(YP + (size_t)mn * D) + lane;
#pragma unroll
          for (int j = 0; j < 4; ++j) { nx[j] = xn[64 * j]; ny[j] = yr[64 * j]; } }
        const float mean = wave_sum(s) * (1.f / D); float s2 = 0.f;
#pragma unroll
        for (int j = 0; j < 4; ++j) { v[j] = v[j] - mean; s2 += (v[j].x * v[j].x + v[j].y * v[j].y) + (v[j].z * v[j].z + v[j].w * v[j].w); }
        const float rstd = 1.f / sqrtf(wave_sum(s2) * (1.f / D) + LN_EPS);
#pragma unroll
        for (int j = 0; j < 4; ++j) { const f32x4 gg = *(const GAS f32x4*)(lg + 256 * j + 4 * lane), bb = *(const GAS f32x4*)(lb + 256 * j + 4 * lane); xr[64 * j] = v[j] * rstd * gg + bb; }
    }
}

__device__ __forceinline__ int opaque_i(int v) { asm volatile("" : "+v"(v)); return v; }
constexpr int NPHASE = 13;
struct Args { const float* in[21]; float* out; unsigned char* ws; int ph_lo, ph_hi; };
__global__ void __launch_bounds__(NTHR, 2) fwd(Args args) {
    extern __shared__ __attribute__((aligned(16))) unsigned char lds_raw[];
    LAS unsigned char* lds = (LAS unsigned char*)lds_raw;
    volatile LAS unsigned* MISC = (volatile LAS unsigned*)(lds + MISC_OFF);
    const int tid0 = threadIdx.x, wave = __builtin_amdgcn_readfirstlane(tid0 >> 6), G = gridDim.x;
    unsigned char* ws = args.ws; gu32* ctl = (gu32*)(ws + WS_CTL);
    for (int u = tid0; u < (LDS_BYTES - LDSCTL_OFF) / 4; u += NTHR) ((LAS unsigned*)(lds + LDSCTL_OFF))[u] = 0u;
    __syncthreads();
    const int lo = args.ph_lo, hi = args.ph_hi;
    const bool multi = (hi - lo) > 1;
    XcdBarrier bar; bar.bar = (unsigned*)(ctl + CW_BAR); bar.x = 0; bar.st = nullptr;
    if (multi) bar = xcd_barrier_post((unsigned*)(ctl + CW_BAR), MISC + 8);
    if (multi && tid0 == 0) { const unsigned xc = xb_xcc_id(); MISC[16] = xc; MISC[17] = xb_add((unsigned*)(ctl + CW_RANK + 64 * (xc & 15u)), 1u); }
#ifndef PROBE_PHASE
#define PROBE_PHASE -1
#endif
#define IN(k) (lo <= (k) && (k) < hi)
#define PT const int tid = opaque_i(tid0), lane = tid & 63
#ifndef PROBE_PHASE
#define PROBE_PHASE -1
#endif
#define REP(k) for (int rep_ = 0; rep_ < ((k) == PROBE_PHASE ? 2 : 1); ++rep_)
#define SEAM(k) do { if (IN(k) && IN((k) + 1)) { for (int r_ = 0; r_ < (PROBE_PHASE == 200 ? 3 : 1); ++r_) xcd_barrier(bar); } DELAYP(k); } while (0)
#if PROBE_PHASE >= 300
    unsigned long long tprev_ = rt();
#define DELAYP(k) do { const unsigned long long now_ = rt(); if ((k) == PROBE_PHASE - 300) { while (rt() - now_ < now_ - tprev_) __builtin_amdgcn_s_sleep(8); } tprev_ = rt(); } while (0)
#else
#define DELAYP(k) do { } while (0)
#endif

    if (IN(0)) REP(0) { PT; p0_prologue(lds, args.in, ws, tid, lane, wave, G); }
    SEAM(0);
    if (IN(1)) REP(1) { PT; p1_ln_pass(lds, args.in, ws, tid, lane, wave, G); }
    SEAM(1);
    if (IN(2)) REP(2) {
        pg8::Gemm g{(const bf16*)(ws + WS_R1), (const bf16*)(ws + WS_WIN), M, NIN, D}; pg8::StaticOrder S; S.init(M, NIN, G, (int)blockIdx.x);
        pg8::EpiInproj E{(bf16*)(ws + WS_Q), (bf16*)(ws + WS_G), (bf16*)(ws + WS_SGA), (WS_K - WS_Q) / 2, (WS_SGB - WS_SGA) / 2, QSCALE, (unsigned*)(ctl + CW_AQ + 128)};
        pg8::gemm_phase<pg8::EpiInproj, pg8::StaticOrder, true, true>(lds + RING_OFF, g, S, E);
        __syncthreads();
        PT;
        { const int nwg = (M / 256) * (NIN / 256), first = nwg % G;
          if ((int)blockIdx.x >= first) { volatile LAS unsigned* tk = MISC + 20;
              for (int n = 0; n < 4; ++n) { __syncthreads(); if (tid == 0) *tk = xb_add((unsigned*)(ctl + CW_AQ + 320), 1u); __syncthreads(); const int u = __builtin_amdgcn_readfirstlane((int)*tk); if (u >= TC_TICKETS) break; tc_tables(args.in, ws, u, lane, wave); } } }
        for (int bh = G - 1 - (int)blockIdx.x; bh < BATCH * NH; bh += G) p2_scan(lds, ws, bh, tid, lane, wave);
    }
    SEAM(2);
    if (IN(3)) {
        { static_assert(attn_body::ATTN_LDS_BYTES + 64 <= RING_BYTES && attn_body::ATTN_PITCH == AW, "attention body geometry vs frame");
          const attn_body::AttnTensors AT{(const attn_body::bf16*)(ws + WS_Q), (const attn_body::bf16*)(ws + WS_K), (const attn_body::bf16*)(ws + WS_V), (attn_body::bf16*)(ws + WS_AO), (const float*)(ws + WS_FB)};
          const int vcu = (G % 8 == 0) ? ((int)blockIdx.x % 8) * (G / 8) + (int)blockIdx.x / 8 : (int)blockIdx.x;
          attn_body::attn_phase<8>((char*)lds_raw + RING_OFF, AT, (unsigned*)(ctl + CW_AQ), (unsigned*)(ctl + CW_AQ + 128), vcu, G); }
        __syncthreads();
        { PT; volatile LAS unsigned* tk = MISC + 20;
          for (;;) { __syncthreads(); if (tid == 0) *tk = xb_add((unsigned*)(ctl + CW_AQ + 256), 1u); __syncthreads(); const int u = __builtin_amdgcn_readfirstlane((int)*tk); if (u >= M / 32) break;
              p3_conv_unit(lds, args.in, ws, u, tid, lane, wave); }
          for (;;) { __syncthreads(); if (tid == 0) *tk = xb_add((unsigned*)(ctl + CW_AQ + 320), 1u); __syncthreads(); const int u = __builtin_amdgcn_readfirstlane((int)*tk); if (u >= TC_TICKETS) break; tc_tables(args.in, ws, u, lane, wave); } }
    }
    SEAM(3);
    if (IN(4)) REP(4) {
        pg8::StaticOrder S; S.init(M, D, G, (int)blockIdx.x);
        { pg8::Gemm g{(const bf16*)(ws + WS_AO), (const bf16*)(ws + WS_WA), M, D, AW}; pg8::EpiGate<0> E{(const bf16*)(ws + WS_SGA), (bf16*)(ws + WS_R1)};
          pg8::gemm_phase<pg8::EpiGate<0>, pg8::StaticOrder, true, true>(lds + RING_OFF, g, S, E); }
        __syncthreads();
        { pg8::Gemm g{(const bf16*)(ws + WS_HC), (const bf16*)(ws + WS_WB), M, D, CC}; pg8::EpiGate<1> E{(const bf16*)(ws + WS_SGB), (bf16*)(ws + WS_R1)};
          pg8::gemm_phase<pg8::EpiGate<1>, pg8::StaticOrder, true, true>(lds + RING_OFF, g, S, E); }
    }
    SEAM(4);
    if (IN(5)) REP(5) {
        pg8::Gemm g{(const bf16*)(ws + WS_R1), (const bf16*)(ws + WS_WO), M, D, D}; pg8::StaticOrder S; S.init(M, D, G, (int)blockIdx.x);
        pg8::EpiB16 E{(bf16*)(ws + WS_OUTF), D};
        pg8::gemm_phase<pg8::EpiB16, pg8::StaticOrder, true, true>(lds + RING_OFF, g, S, E);
    }
    SEAM(5);
    if (IN(6)) REP(6) { PT; p6_ln_pass(lds, args.in, args.out, ws, tid, lane, wave, G); }
    SEAM(6);
    if (IN(7)) REP(7) {
        pg8::Gemm g{(const bf16*)(ws + WS_R1), (const bf16*)(ws + WS_WQ), M, D, D}; pg8::StaticOrder S; S.init(M, D, G, (int)blockIdx.x);
        pg8::EpiF32 E{(float*)(ws + WS_QP), D};
        pg8::gemm_phase<pg8::EpiF32, pg8::StaticOrder, true, true>(lds + RING_OFF, g, S, E);
    }
    if (IN(7) && IN(8)) { VM_WAIT(); __syncthreads(); }
    if (IN(8)) REP(8) { PT; pg8::StaticOrder S; S.init(M, D, G, (int)blockIdx.x); p8_topk(lds, args.in, ws, tid, lane, wave, S); }
    SEAM(8);
    int sl = (int)blockIdx.x & 7, tb = (int)blockIdx.x >> 3; const int ntb = G >> 3;
    if (IN(9) || IN(11)) {
        if (multi && lo < 9) {
            if (tid0 == 0) { bool uni = (G & 7) == 0;
                for (int j = 0; j < 16; ++j) { const unsigned c = xb_ld((unsigned*)(ctl + CW_BAR) + XB_XCNT(j)); uni = uni && (c == (j < 8 ? (unsigned)(G >> 3) : 0u)); }
                MISC[18] = uni ? 1u : 0u; }
            __syncthreads();
            if (MISC[18]) { sl = (int)MISC[16]; tb = (int)MISC[17]; }
        }
    }
    if (IN(9)) REP(9) { PT; p9_g1(lds, ws, lane, wave, sl, tb, ntb); }
    SEAM(9);
    if (IN(10)) { PT; p10_w(ws, lane, wave, G); }
    SEAM(10);
    if (IN(11)) REP(11) { PT; p11_g2(lds, ws, lane, wave, sl, tb, ntb); }
    SEAM(11);
    if (IN(12)) { PT; p12_final(lds, args.in, args.out, ws, tid, lane, wave, G); }
    DELAYP(12);
#undef IN
#undef SEAM
}

#ifndef MK_ONE_LAUNCH
#define MK_ONE_LAUNCH 1
#endif
extern "C" void kernel_launch(void* const* d_in, const int* in_sizes, int n_in, void* d_out, int out_size, void* d_ws, size_t ws_size, hipStream_t stream) {
    static int grid = 0;
    if (grid == 0) {
        if (n_in != 21 || out_size != M * D || ws_size < WS_END) { fprintf(stderr, "kernel_launch: unexpected problem shape (n_in %d, out %d, ws %zu)\n", n_in, out_size, ws_size); grid = -1; return; }
        int dev = 0, cus = 0, per_cu = 0;
        if (hipGetDevice(&dev) != hipSuccess || hipDeviceGetAttribute(&cus, hipDeviceAttributeMultiprocessorCount, dev) != hipSuccess) { grid = -1; return; }
        if (hipFuncSetAttribute((const void*)fwd, hipFuncAttributeMaxDynamicSharedMemorySize, LDS_BYTES) != hipSuccess) { fprintf(stderr, "kernel_launch: hipFuncSetAttribute failed\n"); grid = -1; return; }
        if (hipOccupancyMaxActiveBlocksPerMultiprocessor(&per_cu, (const void*)fwd, NTHR, LDS_BYTES) != hipSuccess || per_cu < 1) { fprintf(stderr, "kernel_launch: occupancy query says %d\n", per_cu); }
        (void)hipGetLastError();
        grid = cus;
    }
    if (grid < 0) return;
    if (hipMemsetAsync((char*)d_ws + WS_CTL, 0, CTL_ZERO_BYTES, stream) != hipSuccess) return;
    Args a{};
    for (int i = 0; i < 21; ++i) a.in[i] = (const float*)d_in[i];
    a.out = (float*)d_out; a.ws = (unsigned char*)d_ws;
#if MK_ONE_LAUNCH
    a.ph_lo = 0; a.ph_hi = NPHASE;
    hipLaunchKernelGGL(fwd, dim3(grid), dim3(NTHR), LDS_BYTES, stream, a);
#else
    for (int p = 0; p < NPHASE; ++p) { a.ph_lo = p; a.ph_hi = p + 1; hipLaunchKernelGGL(fwd, dim3(grid), dim3(NTHR), LDS_BYTES, stream, a); }
#endif
}
```

```cpp
#include <hip/hip_runtime.h>
#include <hip/hip_bf16.h>
#include <cstdio>
#include <cstdint>
#include <cmath>
namespace pg8 {
#define PG8_LAS __attribute__((address_space(3)))
typedef unsigned short bf16_t;
typedef short bf16x8 __attribute__((ext_vector_type(8)));
typedef float f32x4 __attribute__((ext_vector_type(4)));
typedef unsigned u32x4 __attribute__((ext_vector_type(4)));
constexpr int BM = 256, BK = 64, HALF = 128, HTB = HALF * BK * 2  , STAGE_BYTES = 8 * HTB, NXCD = 8, WGM = 8;

__host__ __device__ __forceinline__ int lds_byte(int r, int c) { const int st = (r >> 4) * 2 + (c >> 5), rr = r & 15, cc = c & 31, ob = rr * 64 + cc * 2; return st * 1024 + (ob ^ (((ob >> 9) & 1) << 5)); }
__host__ __device__ __forceinline__ void stage_rc(int b, int& R, int& C) { const int st = b / 1024, sb = b % 1024, swz = sb ^ (((sb >> 9) & 1) << 5); R = (st >> 1) * 16 + swz / 64; C = (st & 1) * 32 + (swz % 64) / 2; }
__host__ __device__ __forceinline__ int perm32(int rho) { const int n = rho >> 4, i = rho & 15; return 8 * (i >> 2) + 4 * n + (i & 3); }

struct Unit { int pm, pn; };
struct Gemm { const bf16_t* A; const bf16_t* Bt; int M, N, K; };

struct StaticOrder {
    int nM, nN, nwg, G, c;
    __host__ __device__ void init(int M, int N, int G_, int c_) { nM = M / BM; nN = N / BM; nwg = nM * nN; G = G_; c = c_; }
    __host__ __device__ bool next(int i, Unit& u) const {
        const long L = (long)i * G + c; if (L >= nwg) return false;
        int wgid = (int)L; { const int q = nwg / NXCD, r = nwg % NXCD, xcd = wgid % NXCD, off = wgid / NXCD; wgid = (xcd < r ? xcd * (q + 1) : r * (q + 1) + (xcd - r) * q) + off; }
        const int nig = WGM * nN, gid = wgid / nig, fm = gid * WGM, gsz = (nM - fm) < WGM ? (nM - fm) : WGM;
        u.pm = fm + ((wgid % nig) % gsz); u.pn = (wgid % nig) / gsz; return true;
    }
    __device__ __forceinline__ void a_ready(const Unit&) const {}
    __device__ __forceinline__ void done(const Unit&) const {}
};

__device__ __forceinline__ unsigned cvt_pk_bf16(float lo, float hi) { unsigned r; asm volatile("v_cvt_pk_bf16_f32 %0, %1, %2" : "=v"(r) : "v"(lo), "v"(hi)); return r; }
typedef float f32x2 __attribute__((ext_vector_type(2)));
__device__ __forceinline__ float sigm(float x) { return __builtin_amdgcn_rcpf(1.0f + __expf(-x)); }
__device__ __forceinline__ float bflo(unsigned w) { return __uint_as_float(w << 16); }
__device__ __forceinline__ float bfhi(unsigned w) { return __uint_as_float(w & 0xffff0000u); }
__device__ __forceinline__ u32x4 pack8(const f32x4& v0, const f32x4& v1) { u32x4 w; w.x = cvt_pk_bf16(v0[0], v0[1]); w.y = cvt_pk_bf16(v0[2], v0[3]); w.z = cvt_pk_bf16(v1[0], v1[1]); w.w = cvt_pk_bf16(v1[2], v1[3]); return w; }

struct EpiInproj {
    static constexpr bool PERM = true, AFTER_DRAIN = false;
    bf16_t *Q, *G, *SGA; size_t qkv_stride, sg_stride; float qscale;
    unsigned* km2h;
    __device__ __forceinline__ void operator()(const f32x4 (&acc)[2][2][4][2], const Unit& u, int wr, int wc, int fr, int fq) const {
        const int row0 = u.pm * BM + wr * 64 + fr; const int pn = u.pn;
        if (pn >= 6 && pn < 10) {
            const int ch0 = (pn - 6) * 128 + wc * 32 + 8 * fq;
#pragma unroll
            for (int ai = 0; ai < 2; ++ai)
#pragma unroll
                for (int m = 0; m < 4; ++m) { const int row = row0 + ai * HALF + m * 16; f32x4 g0, g1;
#pragma unroll
                    for (int j = 0; j < 4; ++j) { g0[j] = acc[ai][0][m][0][j] * sigm(acc[ai][1][m][0][j]); g1[j] = acc[ai][0][m][1][j] * sigm(acc[ai][1][m][1][j]); }
                    *(u32x4*)(G + (size_t)row * 512 + ch0) = pack8(g0, g1); }
        } else {
            bf16_t* base; int ldc, colt; float sc = 1.f; bool sg = false;
            if (pn < 6) { base = Q + (size_t)(pn >> 1) * qkv_stride; ldc = 512; colt = (pn & 1) * 256; if (pn < 2) sc = qscale; }
            else { base = SGA + (size_t)((pn - 10) >> 2) * sg_stride; ldc = 1024; colt = ((pn - 10) & 3) * 256; sg = true; }
            const int col0 = colt + wc * 32 + 8 * fq;
            if (pn == 2 || pn == 3) {
#pragma unroll
                for (int bj = 0; bj < 2; ++bj) { float mx = 0.f;
#pragma unroll
                    for (int ai = 0; ai < 2; ++ai)
#pragma unroll
                        for (int m = 0; m < 4; ++m) { const f32x4 a = acc[ai][bj][m][0], b = acc[ai][bj][m][1]; float ss = (a[0] * a[0] + a[1] * a[1]) + (a[2] * a[2] + a[3] * a[3]) + (b[0] * b[0] + b[1] * b[1]) + (b[2] * b[2] + b[3] * b[3]);
                            { const auto r = __builtin_amdgcn_permlane16_swap(__float_as_uint(ss), __float_as_uint(ss), false, false); ss = __uint_as_float(r[0]) + __uint_as_float(r[1]); }
                            { const auto r = __builtin_amdgcn_permlane32_swap(__float_as_uint(ss), __float_as_uint(ss), false, false); ss = __uint_as_float(r[0]) + __uint_as_float(r[1]); }
                            mx = fmaxf(mx, ss); }
#pragma unroll
                    for (int o = 1; o < 16; o <<= 1) mx = fmaxf(mx, __shfl_xor(mx, o));
                    if ((threadIdx.x & 63) == 0) __hip_atomic_fetch_max(km2h + (((u.pm >> 4) * 8 + (pn - 2) * 4 + 2 * bj + (wc >> 1)) * 2 + (wc & 1)), __float_as_uint(mx * 1.02f), __ATOMIC_RELAXED, __HIP_MEMORY_SCOPE_AGENT); }
            }
#pragma unroll
            for (int ai = 0; ai < 2; ++ai)
#pragma unroll
                for (int m = 0; m < 4; ++m) { bf16_t* rowp = base + (size_t)(row0 + ai * HALF + m * 16) * ldc + col0;
#pragma unroll
                    for (int bj = 0; bj < 2; ++bj) { f32x4 v0 = acc[ai][bj][m][0], v1 = acc[ai][bj][m][1];
                        if (sg) {
#pragma unroll
                            for (int j = 0; j < 4; ++j) { v0[j] = sigm(v0[j]); v1[j] = sigm(v1[j]); } }
                        else { v0 = v0 * sc; v1 = v1 * sc; }
                        *(u32x4*)(rowp + bj * HALF) = pack8(v0, v1); } }
        }
    }
};
template <int MODE> struct EpiGate {
    static constexpr bool PERM = true, AFTER_DRAIN = false;
    const bf16_t* S; bf16_t* O;
    __device__ __forceinline__ void operator()(const f32x4 (&acc)[2][2][4][2], const Unit& u, int wr, int wc, int fr, int fq) const {
        const int row0 = u.pm * BM + wr * 64 + fr; const int col0 = u.pn * BM + wc * 32 + 8 * fq;
#pragma unroll
        for (int ai = 0; ai < 2; ++ai)
#pragma unroll
            for (int m = 0; m < 4; ++m) { const size_t off = (size_t)(row0 + ai * HALF + m * 16) * 1024 + col0;
#pragma unroll
                for (int bj = 0; bj < 2; ++bj) { const u32x4 s = *(const u32x4*)(S + off + bj * HALF); f32x4 v0 = acc[ai][bj][m][0], v1 = acc[ai][bj][m][1];
                    v0[0] *= bflo(s.x); v0[1] *= bfhi(s.x); v0[2] *= bflo(s.y); v0[3] *= bfhi(s.y); v1[0] *= bflo(s.z); v1[1] *= bfhi(s.z); v1[2] *= bflo(s.w); v1[3] *= bfhi(s.w);
                    if (MODE == 1) { const u32x4 t = *(const u32x4*)(O + off + bj * HALF);
                        v0[0] += bflo(t.x); v0[1] += bfhi(t.x); v0[2] += bflo(t.y); v0[3] += bfhi(t.y); v1[0] += bflo(t.z); v1[1] += bfhi(t.z); v1[2] += bflo(t.w); v1[3] += bfhi(t.w); }
                    *(u32x4*)(O + off + bj * HALF) = pack8(v0, v1); } }
    }
};
struct EpiF32 {
    static constexpr bool PERM = false, AFTER_DRAIN = false;
    float* O; int ldc;
    __device__ __forceinline__ void operator()(const f32x4 (&acc)[2][2][4][2], const Unit& u, int wr, int wc, int fr, int fq) const {
        const int row0 = u.pm * BM + wr * 64 + fr; const int col0 = u.pn * BM + wc * 32 + 4 * fq;
#pragma unroll
        for (int ai = 0; ai < 2; ++ai)
#pragma unroll
            for (int m = 0; m < 4; ++m) { float* rowp = O + (size_t)(row0 + ai * HALF + m * 16) * ldc + col0;
#pragma unroll
                for (int bj = 0; bj < 2; ++bj)
#pragma unroll
                    for (int n = 0; n < 2; ++n) *(f32x4*)(rowp + bj * HALF + n * 16) = acc[ai][bj][m][n]; }
    }
};

struct EpiB16 {
    static constexpr bool PERM = true, AFTER_DRAIN = false;
    bf16_t* O; int ldc;
    __device__ __forceinline__ void operator()(const f32x4 (&acc)[2][2][4][2], const Unit& u, int wr, int wc, int fr, int fq) const {
        const int row0 = u.pm * BM + wr * 64 + fr; const int col0 = u.pn * BM + wc * 32 + 8 * fq;
#pragma unroll
        for (int ai = 0; ai < 2; ++ai)
#pragma unroll
            for (int m = 0; m < 4; ++m) { bf16_t* rowp = O + (size_t)(row0 + ai * HALF + m * 16) * ldc + col0;
#pragma unroll
                for (int bj = 0; bj < 2; ++bj) *(u32x4*)(rowp + bj * HALF) = pack8(acc[ai][bj][m][0], acc[ai][bj][m][1]); }
    }
};

template <class Epi, class Sched, bool ALIGN_EPI = false, bool SP2 = false>
__device__ __forceinline__ void gemm_phase(PG8_LAS unsigned char* lds, const Gemm g, const Sched& S, const Epi& E) {
    const int tid = threadIdx.x, wid = __builtin_amdgcn_readfirstlane(tid >> 6), lane = tid & 63, wr = wid >> 2, wc = wid & 3, fr = lane & 15, fq = lane >> 4;
    const int K = g.K, nt = K / BK;
    unsigned voffA[2], voffB[2];
#pragma unroll
    for (int i = 0; i < 2; ++i) { int R, C; stage_rc(tid * 16 + i * 8192, R, C); const int Rb = Epi::PERM ? ((R & ~31) + perm32(R & 31)) : R;
        voffA[i] = (unsigned)(R * K + C) * 2u; voffB[i] = (unsigned)(Rb * K + C) * 2u; }
    const size_t kstep = (size_t)(BK * 2);
    const size_t hstep = (size_t)HALF * K * 2;
    const size_t tstep = 2 * hstep;
    const unsigned ldsw = (unsigned)wid * 1024u;
    const int aoff = lds_byte(wr * 64 + fr, fq * 8), boff = lds_byte(wc * 32 + fr, fq * 8);
#define PG8_SA(b, h) (((b) * 2 + (h)) * HTB)
#define PG8_SB(b, h) ((4 + (b) * 2 + (h)) * HTB)
#define PG8_STAGE(bufoff, gbase, voff) do { _Pragma("unroll") for (int _i = 0; _i < 2; ++_i) \
        __builtin_amdgcn_global_load_lds((const unsigned*)((const char*)(gbase) + (voff)[_i]), (PG8_LAS unsigned*)(lds + (bufoff) + ldsw + _i * 8192), 16, 0, 0); } while (0)
#define PG8_LDA(dst, b, h) do { _Pragma("unroll") for (int m = 0; m < 4; ++m) _Pragma("unroll") for (int k = 0; k < 2; ++k) dst[m][k] = *(const PG8_LAS bf16x8*)(lds + PG8_SA(b, h) + aoff + m * 2048 + k * 1024); } while (0)
#define PG8_LDB(dst, b, h) do { _Pragma("unroll") for (int n = 0; n < 2; ++n) _Pragma("unroll") for (int k = 0; k < 2; ++k) dst[n][k] = *(const PG8_LAS bf16x8*)(lds + PG8_SB(b, h) + boff + n * 2048 + k * 1024); } while (0)
#define PG8_MMA(ai, bj, At, Bt) do { __builtin_amdgcn_s_setprio(1); _Pragma("unroll") for (int m = 0; m < 4; ++m) _Pragma("unroll") for (int n = 0; n < 2; ++n) _Pragma("unroll") for (int k = 0; k < 2; ++k) \
        acc[ai][bj][m][n] = __builtin_amdgcn_mfma_f32_16x16x32_bf16(Bt[n][k], At[m][k], acc[ai][bj][m][n], 0, 0, 0); __builtin_amdgcn_s_setprio(0); } while (0)
#define PG8_WAIT_V(n) asm volatile("s_waitcnt vmcnt(" #n ")" ::: "memory")
#define PG8_WAIT_L(n) asm volatile("s_waitcnt lgkmcnt(" #n ")" ::: "memory")
#define PG8_BAR __builtin_amdgcn_s_barrier()
#define PG8_SCHED __builtin_amdgcn_sched_barrier(0)
    Unit cur, nxt; int ui = 0;
    if (!S.next(0, cur)) return;
    f32x4 acc[2][2][4][2];
#pragma unroll
    for (int a = 0; a < 2; ++a)
#pragma unroll
        for (int b = 0; b < 2; ++b)
#pragma unroll
            for (int m = 0; m < 4; ++m)
#pragma unroll
                for (int n = 0; n < 2; ++n) acc[a][b][m][n] = (f32x4){0.f, 0.f, 0.f, 0.f};
    bf16x8 At[4][2], B0[2][2], B1[2][2];
    const char* cA = (const char*)g.A + (size_t)cur.pm * tstep; const char* cB = (const char*)g.Bt + (size_t)cur.pn * tstep;
    S.a_ready(cur);
    if constexpr (SP2) {
        PG8_STAGE(PG8_SB(0, 0), cB, voffB); PG8_STAGE(PG8_SB(0, 1), cB + hstep, voffB); PG8_STAGE(PG8_SA(0, 0), cA, voffA); PG8_STAGE(PG8_SA(0, 1), cA + hstep, voffA);
        if (wr == 1) PG8_BAR;
        PG8_WAIT_V(2); PG8_BAR;
        PG8_STAGE(PG8_SB(1, 0), cB + kstep, voffB); PG8_STAGE(PG8_SA(1, 0), cA + kstep, voffA); PG8_STAGE(PG8_SB(1, 1), cB + hstep + kstep, voffB);
        PG8_WAIT_V(6); PG8_BAR;
    } else {
        PG8_STAGE(PG8_SB(0, 0), cB, voffB); PG8_STAGE(PG8_SA(0, 0), cA, voffA); PG8_STAGE(PG8_SB(0, 1), cB + hstep, voffB); PG8_STAGE(PG8_SA(0, 1), cA + hstep, voffA);
        if (wr == 1) PG8_BAR;
        PG8_WAIT_V(4); PG8_BAR;
        PG8_STAGE(PG8_SB(1, 0), cB + kstep, voffB); PG8_STAGE(PG8_SA(1, 0), cA + kstep, voffA); PG8_STAGE(PG8_SB(1, 1), cB + hstep + kstep, voffB);
        PG8_WAIT_V(6); PG8_BAR;
    }
    for (;;) {
        const bool has_next = S.next(ui + 1, nxt);
        const char* nA = has_next ? (const char*)g.A + (size_t)nxt.pm * tstep : cA; const char* nB = has_next ? (const char*)g.Bt + (size_t)nxt.pn * tstep : cB;
        for (int t = 0; t < nt; t += 2) {
            const bool last = (t == nt - 2);
            const char* a1 = cA + (size_t)(t + 1) * kstep;
            const char* a2 = last ? nA : cA + (size_t)(t + 2) * kstep; const char* b2 = last ? nB : cB + (size_t)(t + 2) * kstep;
            const char* a3 = a2 + kstep; const char* b3 = b2 + kstep;
            if (last && has_next) S.a_ready(nxt);
            if constexpr (SP2) {
            PG8_LDB(B0, 0, 0); PG8_LDB(B1, 0, 1); PG8_SCHED; PG8_LDA(At, 0, 0); PG8_STAGE(PG8_SA(1, 1), a1 + hstep, voffA);
            PG8_WAIT_V(8); PG8_WAIT_L(0); PG8_BAR; PG8_MMA(0, 0, At, B0); PG8_MMA(0, 1, At, B1); PG8_BAR; PG8_SCHED;
            PG8_LDA(At, 0, 1); PG8_STAGE(PG8_SB(0, 0), b2, voffB); PG8_STAGE(PG8_SB(0, 1), b2 + hstep, voffB); PG8_STAGE(PG8_SA(0, 0), a2, voffA);
            PG8_WAIT_V(8); PG8_WAIT_L(0); PG8_BAR; PG8_MMA(1, 0, At, B0); PG8_MMA(1, 1, At, B1); PG8_BAR; PG8_SCHED;
            PG8_LDB(B0, 1, 0); PG8_LDB(B1, 1, 1); PG8_SCHED; PG8_LDA(At, 1, 0); PG8_STAGE(PG8_SA(0, 1), a2 + hstep, voffA);
            PG8_WAIT_V(8); PG8_WAIT_L(0); PG8_BAR; PG8_MMA(0, 0, At, B0); PG8_MMA(0, 1, At, B1); PG8_BAR; PG8_SCHED;
            PG8_LDA(At, 1, 1); PG8_STAGE(PG8_SB(1, 0), b3, voffB); PG8_STAGE(PG8_SB(1, 1), b3 + hstep, voffB); PG8_STAGE(PG8_SA(1, 0), a3, voffA);
            PG8_WAIT_V(8); PG8_WAIT_L(0); PG8_BAR; PG8_MMA(1, 0, At, B0); PG8_MMA(1, 1, At, B1); PG8_BAR; PG8_SCHED;
            } else {
            PG8_LDB(B0, 0, 0); PG8_SCHED; PG8_LDA(At, 0, 0); PG8_STAGE(PG8_SA(1, 1), a1 + hstep, voffA);
            PG8_WAIT_L(8); PG8_BAR; PG8_WAIT_L(0); PG8_MMA(0, 0, At, B0); PG8_BAR; PG8_SCHED;
            PG8_LDB(B1, 0, 1); PG8_STAGE(PG8_SB(0, 0), b2, voffB);
            PG8_BAR; PG8_WAIT_L(0); PG8_MMA(0, 1, At, B1); PG8_BAR;
            PG8_LDA(At, 0, 1); PG8_STAGE(PG8_SA(0, 0), a2, voffA);
            PG8_BAR; PG8_WAIT_L(0); PG8_MMA(1, 0, At, B0); PG8_BAR; PG8_SCHED;
            PG8_STAGE(PG8_SB(0, 1), b2 + hstep, voffB);
            PG8_WAIT_V(6); PG8_BAR; PG8_MMA(1, 1, At, B1); PG8_BAR;
            PG8_LDB(B0, 1, 0); PG8_SCHED; PG8_LDA(At, 1, 0); PG8_STAGE(PG8_SA(0, 1), a2 + hstep, voffA);
            PG8_WAIT_L(8); PG8_BAR; PG8_WAIT_L(0); PG8_MMA(0, 0, At, B0); PG8_BAR; PG8_SCHED;
            PG8_LDB(B1, 1, 1); PG8_STAGE(PG8_SB(1, 0), b3, voffB);
            PG8_BAR; PG8_WAIT_L(0); PG8_MMA(0, 1, At, B1); PG8_BAR;
            PG8_LDA(At, 1, 1); PG8_STAGE(PG8_SA(1, 0), a3, voffA);
            PG8_BAR; PG8_WAIT_L(0); PG8_MMA(1, 0, At, B0); PG8_BAR; PG8_SCHED;
            PG8_STAGE(PG8_SB(1, 1), b3 + hstep, voffB);
            PG8_WAIT_V(6); PG8_BAR; PG8_MMA(1, 1, At, B1); PG8_BAR;
            }
        }
        if constexpr (ALIGN_EPI) { if (wr == 0) PG8_BAR; }
        if constexpr (!Epi::AFTER_DRAIN) { E(acc, cur, wr, wc, fr, fq); S.done(cur); }
        if (!has_next) break;
#pragma unroll
        for (int a = 0; a < 2; ++a)
#pragma unroll
            for (int b = 0; b < 2; ++b)
#pragma unroll
                for (int m = 0; m < 4; ++m)
#pragma unroll
                    for (int n = 0; n < 2; ++n) acc[a][b][m][n] = (f32x4){0.f, 0.f, 0.f, 0.f};
        cur = nxt; cA = nA; cB = nB; ++ui;
        if constexpr (ALIGN_EPI) { if (wr == 1) PG8_BAR; }
    }
    PG8_WAIT_V(0);
    if constexpr (!ALIGN_EPI) { if (wr == 0) PG8_BAR; }
    PG8_BAR;
    if constexpr (Epi::AFTER_DRAIN) { E.fused(acc, cur, wr, wc, fr, fq, lds, wid, lane); S.done(cur); }
#undef PG8_SA
#undef PG8_SB
#undef PG8_STAGE
#undef PG8_LDA
#undef PG8_LDB
#undef PG8_MMA
#undef PG8_WAIT_V
#undef PG8_WAIT_L
#undef PG8_BAR
#undef PG8_SCHED
}
}

#ifndef PG8_SP2
#define PG8_SP2 true
#endif
#ifndef PG8_ALIGN
#define PG8_ALIGN true
#endif
#include <hip/hip_bf16.h>
#include <cmath>
namespace attn_body {
using bf16=__hip_bfloat16;
using bf16x8=__attribute__((ext_vector_type(8)))short;
using s16x4=__attribute__((ext_vector_type(4)))short;
using f32x16=__attribute__((ext_vector_type(16)))float;
using u32x4=__attribute__((ext_vector_type(4)))unsigned;
using f32x4b=__attribute__((ext_vector_type(4)))float;
constexpr int BATCH=4,NHEAD=8,SEQ=4096,D=64,DM=NHEAD*D;
constexpr int NW=8,QBLK=32,QB=QBLK*NW,KVBLK=64,NQB=SEQ/QB;
constexpr int ATTN_PITCH=DM, ATTN_UNIT_ROWS=QB;
__device__ __forceinline__ int crow(int r,int hi){return (r&3)+8*(r>>2)+4*hi;}
#define SBAR() __builtin_amdgcn_sched_barrier(0)
__device__ __forceinline__ void cmask(f32x16&p0,f32x16&p1,int jb,int qrel,int hi){
  const float NEG=-INFINITY; int kb=64*jb+4*hi;
  #pragma unroll
  for(int r=0;r<16;++r){int kv=kb+(r&3)+8*(r>>2); if(kv>qrel)p0[r]=NEG; if(kv+32>qrel)p1[r]=NEG;}
}

constexpr int NSLOT=3, SLOTB=8192;
constexpr int LDS_K=0, LDS_V=NSLOT*SLOTB, LDS_WS=2*NSLOT*SLOTB, LDS_OST=LDS_WS+NW*64*4, LDS_BIAS=LDS_OST+NW*4096, LDS_BYTES=LDS_BIAS+SEQ*4;
constexpr float C2=0.125f*1.4426950408889634f;
__device__ __forceinline__ void glds16(const void*gsrc,unsigned lds_dst){unsigned keep;
  asm volatile("s_mov_b32 %0, m0\n\ts_mov_b32 m0, %2\n\ts_nop 0\n\tglobal_load_lds_dwordx4 %1, off\n\ts_mov_b32 m0, %0":"=&s"(keep):"v"(gsrc),"s"(lds_dst):"memory");}
__device__ __forceinline__ float max3f(float a,float b,float c){float r;asm("v_max3_f32 %0, %1, %2, %3":"=v"(r):"v"(a),"v"(b),"v"(c));return r;}
__device__ __forceinline__ float max2f(float a,float b){float r;asm("v_max_f32_e32 %0, %1, %2":"=v"(r):"v"(a),"v"(b));return r;}
__device__ __forceinline__ float fadd_s(float a,float b){float r;asm("v_add_f32_e32 %0, %1, %2":"=v"(r):"v"(a),"v"(b));return r;}
__device__ __forceinline__ float fsub_s(float a,float b){float r;asm("v_sub_f32_e32 %0, %1, %2":"=v"(r):"v"(a),"v"(b));return r;}
typedef float f32x2_t __attribute__((ext_vector_type(2))); typedef __bf16 bf16x2_t __attribute__((ext_vector_type(2)));
__device__ __forceinline__ unsigned cvtpk_s(float lo,float hi){f32x2_t v={lo,hi};bf16x2_t b=__builtin_convertvector(v,bf16x2_t);return __builtin_bit_cast(unsigned,b);}
#define WAIT_BAR(N) asm volatile("s_waitcnt vmcnt(" #N ") lgkmcnt(0)\n\ts_barrier":::"memory")

__device__ __forceinline__ void qkt(f32x16&p0,f32x16&p1,const char*Kslot,const bf16x8*qr,const f32x16&negm,int r32,int hi){
  const char*kb=Kslot+hi*1024+r32*16;
  #pragma unroll
  for(int d0=0;d0<4;++d0){
    const bf16x8 b0=*reinterpret_cast<const bf16x8*>(kb+d0*2048);
    const bf16x8 b1=*reinterpret_cast<const bf16x8*>(kb+d0*2048+512);
    if(d0==0){p0=__builtin_amdgcn_mfma_f32_32x32x16_bf16(b0,qr[0],negm,0,0,0);p1=__builtin_amdgcn_mfma_f32_32x32x16_bf16(b1,qr[0],negm,0,0,0);}
    else{p0=__builtin_amdgcn_mfma_f32_32x32x16_bf16(b0,qr[d0],p0,0,0,0);p1=__builtin_amdgcn_mfma_f32_32x32x16_bf16(b1,qr[d0],p1,0,0,0);}}
}
typedef __attribute__((address_space(3))) const char* lds_cptr;
typedef short v4i16_t __attribute__((ext_vector_type(4)));
__device__ __forceinline__ void kload8(bf16x8*kf,lds_cptr kp){
  kf[0]=*(const __attribute__((address_space(3))) bf16x8*)(kp);      kf[1]=*(const __attribute__((address_space(3))) bf16x8*)(kp+512);
  kf[2]=*(const __attribute__((address_space(3))) bf16x8*)(kp+2048); kf[3]=*(const __attribute__((address_space(3))) bf16x8*)(kp+2560);
  kf[4]=*(const __attribute__((address_space(3))) bf16x8*)(kp+4096); kf[5]=*(const __attribute__((address_space(3))) bf16x8*)(kp+4608);
  kf[6]=*(const __attribute__((address_space(3))) bf16x8*)(kp+6144); kf[7]=*(const __attribute__((address_space(3))) bf16x8*)(kp+6656);
}
__device__ __forceinline__ void kload2(bf16x8*kf,lds_cptr kp,int j){ kf[2*j]=*(const __attribute__((address_space(3))) bf16x8*)(kp+j*2048); kf[2*j+1]=*(const __attribute__((address_space(3))) bf16x8*)(kp+j*2048+512); }
__device__ __forceinline__ s16x4 vtr(lds_cptr p){ return __builtin_bit_cast(s16x4,__builtin_amdgcn_ds_read_tr16_b64_v4i16((__attribute__((address_space(3))) v4i16_t*)p)); }
__device__ __forceinline__ float rowmax(const f32x16&p0,const f32x16&p1){
  float a=max3f(p0[0],p0[1],p1[0]),b=max3f(p0[2],p0[3],p1[1]);a=max3f(a,p1[2],p1[3]);
  #pragma unroll
  for(int r=4;r<16;r+=4){a=max3f(a,p0[r],p0[r+1]);b=max3f(b,p0[r+2],p0[r+3]);a=max3f(a,p1[r],p1[r+1]);b=max3f(b,p1[r+2],p1[r+3]);}
  const float m=max2f(a,b);
  auto rr=__builtin_amdgcn_permlane32_swap(__float_as_uint(m),__float_as_uint(m),false,false);
  return max2f(__uint_as_float(rr[0]),__uint_as_float(rr[1]));
}
__device__ __forceinline__ void pv(f32x16*o,int vb,bf16x8 pa0,bf16x8 pa1,bf16x8 pa2,bf16x8 pa3){
  #pragma unroll
  for(int d0=0;d0<2;++d0){s16x4 lo[4],hi[4];
    #pragma unroll
    for(int ks=0;ks<4;++ks){
      asm volatile("ds_read_b64_tr_b16 %0,%1 offset:%c2":"=&v"(lo[ks]):"v"(vb),"i"(d0*4096+ks*1024):"memory");
      asm volatile("ds_read_b64_tr_b16 %0,%1 offset:%c2":"=&v"(hi[ks]):"v"(vb),"i"(d0*4096+ks*1024+512):"memory");}
    asm volatile("s_waitcnt lgkmcnt(0)":::"memory");SBAR();
    #define PK(k) (bf16x8){lo[k][0],lo[k][1],lo[k][2],lo[k][3],hi[k][0],hi[k][1],hi[k][2],hi[k][3]}
    o[d0]=__builtin_amdgcn_mfma_f32_32x32x16_bf16(pa0,PK(0),o[d0],0,0,0);
    o[d0]=__builtin_amdgcn_mfma_f32_32x32x16_bf16(pa1,PK(1),o[d0],0,0,0);
    o[d0]=__builtin_amdgcn_mfma_f32_32x32x16_bf16(pa2,PK(2),o[d0],0,0,0);
    o[d0]=__builtin_amdgcn_mfma_f32_32x32x16_bf16(pa3,PK(3),o[d0],0,0,0);
    #undef PK
  }
}

#ifndef ATTN_STORE16
#define ATTN_STORE16(p,v) (*(u32x4*)(p)=(v))
#endif
template<int THRL> __device__ __forceinline__ void attn_unit(int b,int h,int qb,int tskip,const bf16*Q,const bf16*__restrict__ K,const bf16*__restrict__ V,bf16*O,const float*FBh,char*shm){
  const int tid=threadIdx.x,lane=tid&63,r32=lane&31,hi=lane>>5; const int wid=__builtin_amdgcn_readfirstlane(tid>>6);
  const long rowbase=(long)b*SEQ; const int q0=qb*QB;
  const bf16*Qw=Q+(rowbase+q0+wid*QBLK)*DM+h*D;
  const int j0=tskip*KVBLK; const bf16*Kh=K+(rowbase+j0)*DM+h*D,*Vh=V+(rowbase+j0)*DM+h*D;
  const unsigned lds0=(unsigned)(uintptr_t)shm;
  float*wsf=(float*)(shm+LDS_WS)+wid*64;
  const bf16*ksrc=Kh+(long)lane*DM+wid*8;
  const bf16*vsrc=Vh+(long)(16*(wid&3)+(lane>>2))*DM+(wid>>2)*32+(lane&3)*8;
  const unsigned kdst=lds0+LDS_K+wid*1024, vdst=lds0+LDS_V+wid*1024;
  #define DMA_K(t,slot) glds16(ksrc+(long)(t)*KVBLK*DM,(unsigned)__builtin_amdgcn_readfirstlane(kdst+(slot)))
  #define DMA_V(t,slot) glds16(vsrc+(long)(t)*KVBLK*DM,(unsigned)__builtin_amdgcn_readfirstlane(vdst+(slot)))
  const int vb0=(int)(lds0+LDS_V)+((lane>>4)&1)*32+(lane&3)*8+(4*hi+((lane&15)>>2))*64;
  const char*Kbase=shm+LDS_K; bf16x8 kf[8];
  const lds_cptr shm3=(lds_cptr)shm; const lds_cptr kp0=shm3+LDS_K+hi*1024+r32*16; const lds_cptr vp0=shm3+LDS_V+((lane>>4)&1)*32+(lane&3)*8+(4*hi+((lane&15)>>2))*64;
  const int NT=(q0+QB)/KVBLK-tskip;
  int hib=hi; asm volatile("":"+v"(hib));
  const __attribute__((address_space(3))) float*biasp=(const __attribute__((address_space(3))) float*)((lds_cptr)shm+LDS_BIAS)+j0+4*hib;
  #define BIAS(P0,P1,t) do{ const __attribute__((address_space(3))) float*bp_=biasp+64*(t); \
    _Pragma("unroll") for(int k_=0;k_<4;++k_){ const f32x4b b0_=*(const __attribute__((address_space(3))) f32x4b*)(bp_+8*k_)-mhat; const f32x4b b1_=*(const __attribute__((address_space(3))) f32x4b*)(bp_+32+8*k_)-mhat; \
      P0[4*k_]+=b0_.x;P0[4*k_+1]+=b0_.y;P0[4*k_+2]+=b0_.z;P0[4*k_+3]+=b0_.w; P1[4*k_]+=b1_.x;P1[4*k_+1]+=b1_.y;P1[4*k_+2]+=b1_.z;P1[4*k_+3]+=b1_.w; } }while(0)
  #define PREB(P0,P1,t) do{ const __attribute__((address_space(3))) float*bp_=biasp+64*(t); \
    _Pragma("unroll") for(int k_=0;k_<4;++k_){ const f32x4b b0_=*(const __attribute__((address_space(3))) f32x4b*)(bp_+8*k_)-mhat; const f32x4b b1_=*(const __attribute__((address_space(3))) f32x4b*)(bp_+32+8*k_)-mhat; \
      P0[4*k_]=b0_.x;P0[4*k_+1]=b0_.y;P0[4*k_+2]=b0_.z;P0[4*k_+3]=b0_.w; P1[4*k_]=b1_.x;P1[4*k_+1]=b1_.y;P1[4*k_+2]=b1_.z;P1[4*k_+3]=b1_.w; } }while(0)
  DMA_K(0,0);DMA_V(0,0);DMA_K(1,SLOTB);
  bf16x8 qr[4];
  #pragma unroll
  for(int d0=0;d0<4;++d0)qr[d0]=*reinterpret_cast<const bf16x8*>(&Qw[(long)r32*DM+d0*16+hi*8]);
  float mhat=0.f,l_reg=0.f;f32x16 o[2];o[0]=f32x16{};o[1]=f32x16{};const f32x16 negm=f32x16{};
  const int qrel=wid*QBLK+r32;
  #define CMASK(P0,P1,t) do{int jb_=(t)-(NT-4); if(jb_>=0)cmask(P0,P1,jb_,qrel,hi);}while(0)
  bool resc=false;
  #define START(P0,P1) do{ const float rm=rowmax(P0,P1); resc=false; \
    { const float dl=rm; mhat=fadd_s(mhat,dl); \
      _Pragma("unroll") for(int r=0;r<16;++r){P0[r]=fsub_s(P0[r],dl);P1[r]=fsub_s(P1[r],dl);} \
      } \
    _Pragma("unroll") for(int r=0;r<16;++r)P0[r]=__builtin_amdgcn_exp2f(P0[r]); }while(0)
  #define RESC() do{ if(resc){ asm volatile("s_waitcnt lgkmcnt(0)":::"memory"); \
      _Pragma("unroll") for(int d_=0;d_<2;++d_) _Pragma("unroll") for(int r=0;r<16;++r)o[d_][r]*=wsf[crow(r,hi)]; } }while(0)
  f32x16 pA0,pA1,pB0,pB1;
  int sl_prev=0,sl_cur=0,sl_next=SLOTB;
  #define ROT() do{sl_prev=sl_cur;sl_cur=sl_next;sl_next=(sl_next==(NSLOT-1)*SLOTB)?0:sl_next+SLOTB;}while(0)
  DMA_K(2,2*SLOTB);
  WAIT_BAR(3);
  qkt(pA0,pA1,Kbase,qr,negm,r32,hi);asm volatile("s_nop 15\n\ts_nop 7":"+v"(pA0),"+v"(pA1));BIAS(pA0,pA1,0);CMASK(pA0,pA1,0);
  START(pA0,pA1);
  PREB(pB0,pB1,1);
  _Pragma("unroll") for(int r=0;r<16;++r)pA1[r]=__builtin_amdgcn_exp2f(pA1[r]);
  WAIT_BAR(0);
  DMA_K(3,0);DMA_V(1,SLOTB);
  ROT();
  kload8(kf,kp0+sl_cur);
  WAIT_BAR(2);
  s16x4 vlo[8],vhi[8]; u32x4 pw0,pw1,pw2,pw3;
  #define PKW(P,B) cvtpk_s(P[B],P[B+1])
  #define PAF(k) __builtin_bit_cast(bf16x8,pw##k)
  #define VFR(i) (bf16x8){vlo[i][0],vlo[i][1],vlo[i][2],vlo[i][3],vhi[i][0],vhi[i][1],vhi[i][2],vhi[i][3]}
  #define PIN(x) asm volatile("":"+v"(x))
  #define MX3(a,b,c) __builtin_fmaxf(__builtin_fmaxf((a),(b)),(c))
  #define GAPA(MF,A0,A1,A2,A3,W0,W1,PW) do{ MF; sacc+=A0; sacc+=A1; sacc+=A2; sacc+=A3; PIN(sacc); W0; W1; PIN(PW); SBAR(); }while(0)
  #define EX(v) __builtin_amdgcn_exp2f(v)
  #define GAPB(MF,X,B) do{ MF; X[B]=EX(X[B]); X[B+1]=EX(X[B+1]); X[B+2]=EX(X[B+2]); X[B+3]=EX(X[B+3]); PIN(X); SBAR(); }while(0)
  #define VRD(i) do{ vlo[i]=vtr(vp_+(((i)>>2)*4096+((i)&3)*1024)); vhi[i]=vtr(vp_+(((i)>>2)*4096+((i)&3)*1024+512)); }while(0)
  #define KRD(G,j) do{ if(G){ kload2(kf,kp0+sl_next,j); SBAR(); } }while(0)
  #define STEP(C0,C1,P0,P1,t,GK,GV,GL,GP) do{ SBAR(); \
    const lds_cptr vp_=vp0+sl_prev; \
    VRD(0); SBAR(); float sacc=(P0[0]+P0[1]); \
    GAPA(C0=__builtin_amdgcn_mfma_f32_32x32x16_bf16(kf[0],qr[0],C0,0,0,0), P0[2],P0[3],P0[4],P0[5],     pw0[0]=PKW(P0,0), pw0[1]=PKW(P0,2), pw0); \
    VRD(4); SBAR(); GAPA(C1=__builtin_amdgcn_mfma_f32_32x32x16_bf16(kf[1],qr[0],C1,0,0,0), P0[6],P0[7],P0[8],P0[9],     pw0[2]=PKW(P0,4), pw0[3]=PKW(P0,6), pw0); \
    VRD(1); SBAR(); GAPA(C0=__builtin_amdgcn_mfma_f32_32x32x16_bf16(kf[2],qr[1],C0,0,0,0),   P0[10],P0[11],P0[12],P0[13], pw1[0]=PKW(P0,8), pw1[1]=PKW(P0,10), pw1); \
    VRD(5); SBAR(); GAPA(C1=__builtin_amdgcn_mfma_f32_32x32x16_bf16(kf[3],qr[1],C1,0,0,0),   P0[14],P0[15],P1[0],P1[1],   pw1[2]=PKW(P0,12),pw1[3]=PKW(P0,14), pw1); \
    VRD(2); SBAR(); GAPA(C0=__builtin_amdgcn_mfma_f32_32x32x16_bf16(kf[4],qr[2],C0,0,0,0),   P1[2],P1[3],P1[4],P1[5],     pw2[0]=PKW(P1,0), pw2[1]=PKW(P1,2), pw2); \
    VRD(6); SBAR(); GAPA(C1=__builtin_amdgcn_mfma_f32_32x32x16_bf16(kf[5],qr[2],C1,0,0,0),   P1[6],P1[7],P1[8],P1[9],     pw2[2]=PKW(P1,4), pw2[3]=PKW(P1,6), pw2); \
    VRD(3); SBAR(); GAPA(C0=__builtin_amdgcn_mfma_f32_32x32x16_bf16(kf[6],qr[3],C0,0,0,0),   P1[10],P1[11],P1[12],P1[13], pw3[0]=PKW(P1,8), pw3[1]=PKW(P1,10), pw3); \
    VRD(7); SBAR(); GAPA(C1=__builtin_amdgcn_mfma_f32_32x32x16_bf16(kf[7],qr[3],C1,0,0,0),   P1[14],P1[15],0.f,0.f,       pw3[2]=PKW(P1,12),pw3[3]=PKW(P1,14), pw3); \
    l_reg+=sacc; \
    if(GK){DMA_K((t)+3,sl_cur);} if(GV){DMA_V((t)+1,sl_next);} \
    CMASK(C0,C1,t); \
    { float a=MX3(C0[0],C0[1],C1[0]),b=MX3(C0[2],C0[3],C1[1]); a=MX3(a,C1[2],C1[3]); \
      _Pragma("unroll") for(int r=4;r<16;r+=4){a=MX3(a,C0[r],C0[r+1]);b=MX3(b,C0[r+2],C0[r+3]);a=MX3(a,C1[r],C1[r+1]);b=MX3(b,C1[r+2],C1[r+3]);} \
      float rm=__builtin_fmaxf(a,b); { auto rr=__builtin_amdgcn_permlane32_swap(__float_as_uint(rm),__float_as_uint(rm),false,false); rm=__builtin_fmaxf(__uint_as_float(rr[0]),__uint_as_float(rr[1])); } \
      resc=false; \
      if(__builtin_expect(__any(rm>(float)THRL),0)){ const float dl=__builtin_fmaxf(rm,0.f); mhat+=dl; \
        _Pragma("unroll") for(int r=0;r<16;++r){C0[r]-=dl;C1[r]-=dl;} \
        const float f=__builtin_amdgcn_exp2f(-dl); l_reg*=f; if(hi==0)wsf[r32]=f; resc=true; } } \
    if(GP){PREB(P0,P1,(t)+1);} \
    SBAR(); \
    GAPB(o[0]=__builtin_amdgcn_mfma_f32_32x32x16_bf16(PAF(0),VFR(0),o[0],0,0,0), C0,0); \
    GAPB(o[1]=__builtin_amdgcn_mfma_f32_32x32x16_bf16(PAF(0),VFR(4),o[1],0,0,0), C0,4); \
    KRD(GL,0); GAPB(o[0]=__builtin_amdgcn_mfma_f32_32x32x16_bf16(PAF(1),VFR(1),o[0],0,0,0), C0,8); \
    KRD(GL,1); GAPB(o[1]=__builtin_amdgcn_mfma_f32_32x32x16_bf16(PAF(1),VFR(5),o[1],0,0,0), C0,12); \
    KRD(GL,2); GAPB(o[0]=__builtin_amdgcn_mfma_f32_32x32x16_bf16(PAF(2),VFR(2),o[0],0,0,0), C1,0); \
    KRD(GL,3); GAPB(o[1]=__builtin_amdgcn_mfma_f32_32x32x16_bf16(PAF(2),VFR(6),o[1],0,0,0), C1,4); \
    GAPB(o[0]=__builtin_amdgcn_mfma_f32_32x32x16_bf16(PAF(3),VFR(3),o[0],0,0,0), C1,8); \
    GAPB(o[1]=__builtin_amdgcn_mfma_f32_32x32x16_bf16(PAF(3),VFR(7),o[1],0,0,0), C1,12); \
    }while(0)
  int t=1;
  #undef CMASK
  #define CMASK(P0,P1,t) do{}while(0)
  for(;t+5<NT;t+=2){
    STEP(pB0,pB1,pA0,pA1,t,true,true,true,true);     WAIT_BAR(2); RESC(); ROT();
    STEP(pA0,pA1,pB0,pB1,t+1,true,true,true,true);   WAIT_BAR(2); RESC(); ROT();
  }
  #undef CMASK
  #define CMASK(P0,P1,t) do{int jb_=(t)-(NT-4); if(jb_>=0)cmask(P0,P1,jb_,qrel,hi);}while(0)
  #define ENDW(tt) do{ if((tt)+3<NT){WAIT_BAR(2);} else if((tt)+2<NT){WAIT_BAR(1);} else {WAIT_BAR(0);} }while(0)
  for(;t+1<NT;t+=2){
    STEP(pB0,pB1,pA0,pA1,t,(t+3<NT),(t+1<NT),(t+1<NT),(t+1<NT));       ENDW(t);   RESC(); ROT();
    STEP(pA0,pA1,pB0,pB1,t+1,(t+4<NT),(t+2<NT),(t+2<NT),(t+2<NT));     ENDW(t+1); RESC(); ROT();
  }
  STEP(pB0,pB1,pA0,pA1,NT-1,false,false,false,false); RESC();
  { float sacc=pB0[0]+pB0[1]; _Pragma("unroll") for(int r=2;r<16;++r)sacc+=pB0[r]; _Pragma("unroll") for(int r=0;r<16;++r)sacc+=pB1[r]; l_reg+=sacc;
    pw0=(u32x4){PKW(pB0,0),PKW(pB0,2),PKW(pB0,4),PKW(pB0,6)};pw1=(u32x4){PKW(pB0,8),PKW(pB0,10),PKW(pB0,12),PKW(pB0,14)};pw2=(u32x4){PKW(pB1,0),PKW(pB1,2),PKW(pB1,4),PKW(pB1,6)};pw3=(u32x4){PKW(pB1,8),PKW(pB1,10),PKW(pB1,12),PKW(pB1,14)};
    SBAR(); pv(o,vb0+sl_cur,PAF(0),PAF(1),PAF(2),PAF(3)); }
  #undef PKW
  #undef PAF
  #undef VFR
  #undef PIN
  #undef MX3
  #undef GAPA
  #undef GAPB
  #undef EX
  #undef VRD
  #undef KRD
  #undef STEP
  #undef ENDW
  {auto rr=__builtin_amdgcn_permlane32_swap(__float_as_uint(l_reg),__float_as_uint(l_reg),false,false);l_reg=__uint_as_float(rr[0])+__uint_as_float(rr[1]);}
  if(hi==0)wsf[32+r32]=l_reg;asm volatile("s_waitcnt lgkmcnt(0)":::"memory");
  float rli[16];
  #pragma unroll
  for(int r=0;r<16;++r)rli[r]=__builtin_amdgcn_rcpf(wsf[32+crow(r,hi)]);
  bf16*Ow=O+(rowbase+q0+wid*QBLK)*DM+h*D;
  { bf16*stg=(bf16*)(shm+LDS_OST)+wid*2048;
    #pragma unroll
    for(int r=0;r<16;++r){const int orow=crow(r,hi);
      #pragma unroll
      for(int d0=0;d0<2;++d0)stg[orow*64+d0*32+r32]=__float2bfloat16(o[d0][r]*rli[r]);}
    asm volatile("s_waitcnt lgkmcnt(0)":::"memory");
    #pragma unroll
    for(int i=0;i<4;++i){const int row=i*8+(lane>>3),ch=lane&7; const u32x4 v=*(const u32x4*)(stg+row*64+ch*8); ATTN_STORE16(Ow+(long)row*DM+ch*8,v);} }
  asm volatile("s_waitcnt lgkmcnt(0)\n\ts_barrier":::"memory");
  #undef BIAS
  #undef PREB
  #undef DMA_K
  #undef DMA_V
  #undef CMASK
  #undef START
  #undef RESC
  #undef ROT
}
constexpr int ATTN_LDS_BYTES=LDS_BYTES;
struct AttnTensors { const bf16* Q; const bf16* K; const bf16* V; bf16* O; const float* FB; };
struct AttnUnit { int bh; int qb; };
typedef __attribute__((address_space(3))) unsigned lds_u32;
__device__ __forceinline__ float sumsq8(const u32x4 w){ float s=0.f;
  #pragma unroll
  for(int e=0;e<4;++e){ const float lo=__uint_as_float(w[e]<<16), hi=__uint_as_float(w[e]&0xffff0000u); s+=lo*lo+hi*hi; } return s; }
template<int THRL=8> __device__ __forceinline__ void attn_phase(char*lds,const AttnTensors&T,unsigned*qctr,unsigned*km2,int vcu,int G){
  lds_u32*misc=(lds_u32*)((lds_cptr)lds+LDS_BYTES);
  const int tid=threadIdx.x;
  if(tid==0)misc[5]=0u;
  int k=vcu;
  for(;;){
    if(k>=BATCH*NHEAD*NQB)break;
    int bh,qb; if(k<256){bh=k>>3;qb=15-(k&7);}else{const int k2=k-256;qb=7-(k2>>5);bh=k2&31;}
    const int b=bh/NHEAD,h=bh%NHEAD,q0=qb*QB; const long rowbase=(long)b*SEQ; const float*FBh=T.FB+(long)bh*SEQ;
    __syncthreads();
    if(tid==0){misc[1]=0u; misc[2]=__float_as_uint(__uint_as_float(__hip_atomic_load(km2+2*bh,__ATOMIC_RELAXED,__HIP_MEMORY_SCOPE_AGENT))+__uint_as_float(__hip_atomic_load(km2+2*bh+1,__ATOMIC_RELAXED,__HIP_MEMORY_SCOPE_AGENT)));}
    __syncthreads();
    { const bf16*qp=T.Q+(rowbase+q0+(tid>>1))*DM+h*D+(tid&1)*32; float s=0.f;
      #pragma unroll
      for(int c=0;c<4;++c)s+=sumsq8(*(const u32x4*)(qp+8*c));
      s+=__shfl_xor(s,1);
      __hip_atomic_fetch_max(misc+1,__float_as_uint(s),__ATOMIC_RELAXED,__HIP_MEMORY_SCOPE_WORKGROUP); }
    __syncthreads();
    if(tid<64){ const float bound=2.0f*sqrtf(__uint_as_float(misc[1])*__uint_as_float(misc[2])); const float thr=FBh[q0]+bound+32.0f; const int NTf=4*qb+4;
      int tl=tid; asm volatile("":"+v"(tl));
      const bool keep=(tl>=NTf)||!(FBh[(tl<NTf?tl:0)*KVBLK+63]>=thr);
      const unsigned long long m=__ballot(keep); int ts=m?__ffsll((long long)m)-1:0; ts=(ts<NTf-4?ts:NTf-4)&~1; if(misc[5])ts=0;
      if(tid==0)misc[4]=(unsigned)ts; }
    { int tl=tid; asm volatile("":"+v"(tl));
      const f32x4b z4={0.f,0.f,0.f,0.f}; const float f0=FBh[q0]; const f32x4b fa=*(const f32x4b*)(FBh+4*tl); const f32x4b fb2=(q0+QB>2048)?*(const f32x4b*)(FBh+2048+4*tl):z4;
      __attribute__((address_space(3))) f32x4b*bl=(__attribute__((address_space(3))) f32x4b*)((lds_cptr)lds+LDS_BIAS);
      bl[tl]=f0-fa; if(q0+QB>2048)bl[512+tl]=f0-fb2; }
    __syncthreads();
    const int tskip=__builtin_amdgcn_readfirstlane((int)misc[4]);
    attn_unit<THRL>(b,h,qb,tskip,T.Q,T.K,T.V,T.O,FBh,lds);
    if(tid==0)misc[0]=(unsigned)G+__hip_atomic_fetch_add(qctr,1u,__ATOMIC_RELAXED,__HIP_MEMORY_SCOPE_AGENT);
    __syncthreads();
    k=__builtin_amdgcn_readfirstlane((int)misc[0]);
  }
}
#undef SBAR
#undef WAIT_BAR
}
#define GAS __attribute__((address_space(1)))
#define LAS __attribute__((address_space(3)))
typedef unsigned short bf16;
typedef unsigned v4u __attribute__((ext_vector_type(4)));
typedef float f32x4 __attribute__((ext_vector_type(4)));
typedef short bf16x8 __attribute__((ext_vector_type(8)));
typedef GAS unsigned gu32;
typedef GAS unsigned long long gu64;
#define RLX_AGENT __ATOMIC_RELAXED, __HIP_MEMORY_SCOPE_AGENT
#define LDS_WAIT() asm volatile("s_waitcnt lgkmcnt(0)" ::: "memory")
#define VM_WAIT() asm volatile("s_waitcnt vmcnt(0)" ::: "memory")
__device__ __forceinline__ unsigned long long rt() { return __builtin_amdgcn_s_memrealtime(); }
__device__ __forceinline__ unsigned f2bf(float f) { unsigned u = __builtin_bit_cast(unsigned, f); return (u + 0x7fffu + ((u >> 16) & 1u)) >> 16; }
__device__ __forceinline__ unsigned pk2(float lo, float hi) { return f2bf(lo) | (f2bf(hi) << 16); }

#define XB_TMO      128
#define XB_XCNT(j)  (256  + 64 * (j))
#define XB_XSUB(j)  (1280 + 64 * (j))
#define XB_XGEN(j)  (2304 + 64 * (j))
#define XB_TOP      3328
#define XB_TOPGEN   3392
#define XCD_BAR_WORDS 3456
#define XB_SPIN_CAP (1u << 18)

__device__ __forceinline__ unsigned xb_ld(unsigned* p)              { return __hip_atomic_load(p, __ATOMIC_RELAXED, __HIP_MEMORY_SCOPE_AGENT); }
__device__ __forceinline__ unsigned xb_add(unsigned* p, unsigned v) { return __hip_atomic_fetch_add(p, v, __ATOMIC_RELAXED, __HIP_MEMORY_SCOPE_AGENT); }
__device__ __forceinline__ unsigned xb_xcc_id() { return (unsigned)__builtin_amdgcn_s_getreg((3 << 11) | 20) & 0xFu; }
#define XB_SPIN(cond, bar) do { unsigned _sp = 0; while (cond) { __builtin_amdgcn_s_sleep(1); \
    if ((++_sp & 255u) == 0u) { if (xb_ld(&(bar)[XB_TMO])) break; if (_sp > XB_SPIN_CAP) { atomicAdd(&(bar)[XB_TMO], 1u); break; } } } } while (0)

struct XcdBarrier {
    unsigned* bar; unsigned x;
    volatile LAS unsigned* st;
};

__device__ __forceinline__ XcdBarrier xcd_barrier_post(unsigned* bar, volatile LAS unsigned* st) {
    XcdBarrier b; b.bar = bar; b.x = xb_xcc_id(); b.st = st;
    if (threadIdx.x == 0) (void)xb_add(&bar[XB_XCNT(b.x)], 1u);
    return b;
}
__device__ __forceinline__ void xcd_barrier_complete(unsigned* bar, unsigned x, unsigned& nloc, unsigned& nx) {
    const unsigned G = gridDim.x * gridDim.y * gridDim.z;
    unsigned sum, cnt, mine, sp = 0u;
    for (;;) {
        sum = 0u; cnt = 0u; mine = 0u;
#pragma unroll
        for (unsigned j = 0; j < 16; ++j) { const unsigned c = xb_ld(&bar[XB_XCNT(j)]); sum += c; cnt += (c > 0u) ? 1u : 0u; mine = (j == x) ? c : mine; }
        if (sum == G) break;
        __builtin_amdgcn_s_sleep(1);
        if ((++sp & 255u) == 0u) { if (xb_ld(&bar[XB_TMO])) break; if (sp > XB_SPIN_CAP) { atomicAdd(&bar[XB_TMO], 1u); break; } }
    }
    nloc = mine > 0u ? mine : 1u; nx = cnt > 0u ? cnt : 1u;
}

__device__ __forceinline__ void xcd_barrier(const XcdBarrier& b) {
    asm volatile("s_waitcnt vmcnt(0)" ::: "memory");
    __syncthreads();
    if (threadIdx.x == 0) {
        unsigned* bar = b.bar;
        __builtin_amdgcn_s_waitcnt(0);
        unsigned nloc = b.st[0], nx = b.st[1];
        if (nloc == 0u) { xcd_barrier_complete(bar, b.x, nloc, nx); b.st[0] = nloc; b.st[1] = nx; }
        const unsigned old = xb_add(&bar[XB_XSUB(b.x)], 1u);
        const unsigned gen = old / nloc;
        if (old + 1u == (gen + 1u) * nloc) {
            __builtin_amdgcn_fence(__ATOMIC_RELEASE, "agent");
            asm volatile("s_waitcnt vmcnt(0)" ::: "memory");
            const unsigned og = xb_add(&bar[XB_TOP], 1u);
            const unsigned tg = og / nx;
            if (og + 1u == (tg + 1u) * nx) xb_add(&bar[XB_TOPGEN], 1u);
            else XB_SPIN(xb_ld(&bar[XB_TOPGEN]) == tg, bar);
            __builtin_amdgcn_fence(__ATOMIC_ACQUIRE, "agent");
            xb_add(&bar[XB_XGEN(b.x)], 1u);
            asm volatile("s_waitcnt vmcnt(0)" ::: "memory");
        } else {
            XB_SPIN(xb_ld(&bar[XB_XGEN(b.x)]) == gen, bar);
            __builtin_amdgcn_fence(__ATOMIC_ACQUIRE, "agent");
            asm volatile("s_waitcnt vmcnt(0)" ::: "memory");
        }
    }
    __syncthreads();
}

constexpr int NWAVES = 8, NTHR = NWAVES * 64;
constexpr int BATCH = 4, SEQ = 4096, D = 1024, M = BATCH * SEQ, NH = 8, HD = 64, AW = 512, CC = 512, CK = 31;
constexpr int WIN_LD = 4616, NIN = 4608;
constexpr int OFF_F = 1536, OFF_CA = 1544, OFF_CB = 2056, OFF_GA = 2568, OFF_GB = 3592;
constexpr int PH = 8, NKEYS = 128, PDH = 64, TOPK = 16, NSEL = PH * TOPK;
constexpr float LN_EPS = 1e-5f, ALPHA = 1.189207115002721f, LOG2E = 1.4426950408889634f;
constexpr float QSCALE = 0.125f * LOG2E;
constexpr int MODW = 6 * D;

constexpr size_t MiB = 1u << 20;
constexpr size_t WS_CTL = 0, CTL_ZERO_BYTES = 65536;
constexpr size_t WS_PART = 1 * MiB;
constexpr size_t WS_LOGF = 1 * MiB + 512 * 1024;
constexpr size_t WS_FB = 2 * MiB;
constexpr size_t WS_WIN = 4 * MiB, WS_WA = 13 * MiB, WS_WB = 14 * MiB, WS_WO = 15 * MiB, WS_WQ = 17 * MiB;
constexpr size_t WS_R1 = 20 * MiB;
constexpr size_t WS_Q = 52 * MiB, WS_K = 68 * MiB, WS_V = 84 * MiB, WS_G = 100 * MiB, WS_HC = 116 * MiB;
constexpr size_t WS_SGA = 132 * MiB, WS_SGB = 164 * MiB;
constexpr size_t WS_OUTF = 132 * MiB;
constexpr size_t WS_QP = 52 * MiB;
constexpr size_t WS_IDX = 116 * MiB, WS_GATE = 124 * MiB;
constexpr size_t WS_SU = 3 * MiB, WS_SV = 3 * MiB + 65536, WS_SX = 3 * MiB + 131072;
constexpr size_t WS_W8 = 244 * MiB;
constexpr size_t WS_U8 = 196 * MiB, WS_V8 = 212 * MiB;
constexpr size_t WS_X8 = 228 * MiB;
constexpr size_t WS_AO = 228 * MiB;
constexpr size_t WS_APART = 132 * MiB;
constexpr size_t WS_YP = 52 * MiB;
constexpr size_t WS_END = 247 * MiB;
constexpr int W8P = 144;
constexpr int NEXP = 16384;
constexpr int CW_TMO = 0, CW_CODE = 1, CW_BAR = 4096, CW_RANK = 8192, CW_AQ = 10240;

constexpr int RING_OFF = 0, RING_BYTES = 131072;
constexpr int LDSCTL_OFF = RING_BYTES, MISC_OFF = LDSCTL_OFF + 320;
constexpr int LDS_BYTES = 147456;

template <int CTRL> __device__ __forceinline__ float dppf(float v) { return __uint_as_float((unsigned)__builtin_amdgcn_update_dpp(0, (int)__float_as_uint(v), CTRL, 0xF, 0xF, true)); }
template <int CTRL> __device__ __forceinline__ int dppi(int v) { return __builtin_amdgcn_update_dpp(0, v, CTRL, 0xF, 0xF, true); }
__device__ __forceinline__ float wave_sum(float v) {
    v += dppf<0xB1>(v); v += dppf<0x4E>(v); v += dppf<0x141>(v); v += dppf<0x140>(v);
    { const auto r = __builtin_amdgcn_permlane16_swap(__float_as_uint(v), __float_as_uint(v), false, false); v = __uint_as_float(r[0]) + __uint_as_float(r[1]); }
    { const auto r = __builtin_amdgcn_permlane32_swap(__float_as_uint(v), __float_as_uint(v), false, false); v = __uint_as_float(r[0]) + __uint_as_float(r[1]); }
    return v;
}
__device__ __forceinline__ float wave_max(float v) {
    v = fmaxf(v, dppf<0xB1>(v)); v = fmaxf(v, dppf<0x4E>(v)); v = fmaxf(v, dppf<0x141>(v)); v = fmaxf(v, dppf<0x140>(v));
    { const auto r = __builtin_amdgcn_permlane16_swap(__float_as_uint(v), __float_as_uint(v), false, false); v = fmaxf(__uint_as_float(r[0]), __uint_as_float(r[1])); }
    { const auto r = __builtin_amdgcn_permlane32_swap(__float_as_uint(v), __float_as_uint(v), false, false); v = fmaxf(__uint_as_float(r[0]), __uint_as_float(r[1])); }
    return v;
}
__device__ __forceinline__ int xlane16(int v, int lane) { const auto r = __builtin_amdgcn_permlane16_swap((unsigned)v, (unsigned)v, false, false); return (lane & 16) ? (int)r[0] : (int)r[1]; }
__device__ __forceinline__ int xlane32(int v, int lane) { const auto r = __builtin_amdgcn_permlane32_swap((unsigned)v, (unsigned)v, false, false); return (lane & 32) ? (int)r[0] : (int)r[1]; }
__device__ __forceinline__ float bf_lo(unsigned w) { return __uint_as_float(w << 16); }
__device__ __forceinline__ float bf_hi(unsigned w) { return __uint_as_float(w & 0xffff0000u); }

__device__ __forceinline__ void p0_transpose_item(const float* W, int ldw, int src_col0, bf16* WT, int K, int dst_row0, int k0, LAS float* scr, int lane) {
#pragma unroll
    for (int i = 0; i < 32; ++i) { const int kk = 2 * i + (lane >> 5); scr[kk * 33 + (lane & 31)] = W[(size_t)(k0 + kk) * ldw + src_col0 + (lane & 31)]; }
    LDS_WAIT(); asm volatile("" ::: "memory");
    const int c = lane & 7;
#pragma unroll
    for (int j = 0; j < 4; ++j) { const int n = (lane >> 3) + 8 * j; const LAS float* s = scr + (8 * c) * 33 + n;
        v4u o; o.x = pk2(s[0 * 33], s[1 * 33]); o.y = pk2(s[2 * 33], s[3 * 33]); o.z = pk2(s[4 * 33], s[5 * 33]); o.w = pk2(s[6 * 33], s[7 * 33]);
        *(GAS v4u*)(WT + (size_t)(dst_row0 + n) * K + k0 + 8 * c) = o; }
    LDS_WAIT(); asm volatile("" ::: "memory");
}
__device__ __forceinline__ int win_src_col(int r) {
    if (r < 1536) return r;
    if (r < 2560) { const int rr = r - 1536, t = rr >> 8, w = rr & 255; return w < 128 ? OFF_CA + 128 * t + w : OFF_CB + 128 * t + (w - 128); }
    if (r < 3584) return OFF_GA + (r - 2560);
    return OFF_GB + (r - 3584);
}
__device__ __forceinline__ void p0_prologue(LAS unsigned char* lds, const float* const* in, unsigned char* ws, int tid, int lane, int wave, int G) {
    LAS float* sl = (LAS float*)(lds + 98304);
#pragma unroll
    for (int it = 0; it < BATCH * D / NTHR; ++it) { const int i = tid + it * NTHR; const float c = in[1][i]; sl[i] = c / (1.0f + __expf(-c)); }
    __syncthreads();
    LAS float* scr = (LAS float*)(lds + wave * 12288);
    const int gw = (int)blockIdx.x * NWAVES + wave, NGW = G * NWAVES;
    constexpr int I_MOD = 192 * 4, I_WIN = 16 * (NIN / 32), I_WA = 8 * 32, I_WB = 8 * 32, I_WO = 16 * 32, I_WQ = 16 * 32;
    constexpr int NITEMS = I_MOD + I_WIN + I_WA + I_WB + I_WO + I_WQ;
    const float* w_mod = in[2]; const float* b_mod = in[3];
    float* part = (float*)(ws + WS_PART);
    for (int it = gw; it < NITEMS; it += NGW) {
        int r = it;
        if (r < I_MOD) {
            const int chunk = r % 192, kq = r / 192, kk = lane >> 3, cq = lane & 7, col = chunk * 32 + cq * 4;
            f32x4 acc[4];
#pragma unroll
            for (int b = 0; b < 4; ++b) acc[b] = (f32x4){0.f, 0.f, 0.f, 0.f};
#pragma unroll
            for (int i = 0; i < 32; ++i) { const int k = kq * 256 + i * 8 + kk; const f32x4 w = *(const GAS f32x4*)(w_mod + (size_t)k * MODW + col);
#pragma unroll
                for (int b = 0; b < 4; ++b) acc[b] += w * sl[b * D + k]; }
#pragma unroll
            for (int b = 0; b < 4; ++b)
#pragma unroll
                for (int j = 0; j < 4; ++j) { float v = acc[b][j]; v += __shfl_xor(v, 8); v += __shfl_xor(v, 16); v += __shfl_xor(v, 32); acc[b][j] = v; }
            if (kk == 0) {
                f32x4 bias = (f32x4){0.f, 0.f, 0.f, 0.f}; if (kq == 0) bias = *(const GAS f32x4*)(b_mod + col);
#pragma unroll
                for (int b = 0; b < 4; ++b) *(GAS f32x4*)(part + (size_t)(kq * 4 + b) * MODW + col) = acc[b] + bias;
            }
            continue;
        }
        r -= I_MOD;
        const float* W; int ldw, scol, K, drow, k0; size_t dsto;
        if (r < I_WIN) { const int kb = r / (NIN / 32), db = r % (NIN / 32); W = in[4]; ldw = WIN_LD; scol = win_src_col(32 * db); K = D; drow = 32 * db; k0 = 64 * kb; dsto = WS_WIN; }
        else { r -= I_WIN; ldw = D; scol = 32 * (r % 32); drow = scol;
            if (r < I_WA) { W = in[10]; K = AW; dsto = WS_WA; }
            else if ((r -= I_WA) < I_WB) { W = in[11]; K = CC; dsto = WS_WB; }
            else if ((r -= I_WB) < I_WO) { W = in[12]; K = D; dsto = WS_WO; }
            else { r -= I_WO; W = in[15]; K = D; dsto = WS_WQ; }
            scol = 32 * (r % 32); drow = scol; k0 = 64 * (r / 32); }
        p0_transpose_item(W, ldw, scol, (bf16*)(ws + dsto), K, drow, k0, scr, lane);
    }
}
constexpr int TC_TICKETS = 2 * NEXP / 32;
__device__ __forceinline__ void tc_tables(const float* const* in, unsigned char* ws, int ticket, int lane, int wave) {
    { const int row0 = 32 * ticket + 4 * wave;
        f32x4 v[4][4];
#pragma unroll
        for (int r = 0; r < 4; ++r) { const int row = row0 + r; const bool isv = row >= NEXP; const int e = isv ? row - NEXP : row;
            const GAS f32x4* src = (const GAS f32x4*)((isv ? in[18] : in[17]) + (size_t)e * D) + lane;
#pragma unroll
            for (int j = 0; j < 4; ++j) v[r][j] = __builtin_nontemporal_load(src + 64 * j); }
#pragma unroll
        for (int r = 0; r < 4; ++r) { const int row = row0 + r; const bool isv = row >= NEXP; const int e = isv ? row - NEXP : row;
            float am = 0.f;
#pragma unroll
            for (int j = 0; j < 4; ++j) am = fmaxf(am, fmaxf(fmaxf(fabsf(v[r][j].x), fabsf(v[r][j].y)), fmaxf(fabsf(v[r][j].z), fabsf(v[r][j].w))));
            am = wave_max(am);
            const float inv = am > 0.f ? 127.0f / am : 0.f;
            GAS unsigned* dst = (GAS unsigned*)(ws + (isv ? WS_V8 : WS_U8) + (size_t)e * D) + lane;
#pragma unroll
            for (int j = 0; j < 4; ++j) { const int q0 = (int)rintf(v[r][j].x * inv), q1 = (int)rintf(v[r][j].y * inv), q2 = (int)rintf(v[r][j].z * inv), q3 = (int)rintf(v[r][j].w * inv);
                dst[64 * j] = (unsigned)(q0 & 255) | ((unsigned)(q1 & 255) << 8) | ((unsigned)(q2 & 255) << 16) | ((unsigned)(q3 & 255) << 24); }
            if (lane == 0) ((float*)(ws + (isv ? WS_SV : WS_SU)))[e] = am * (1.0f / 127.0f); }
    }
}
template <int NCOLS> __device__ __forceinline__ void load_mod(LAS float* dst, const float* part, int col0, int tid) {
    constexpr int NIT = BATCH * NCOLS / NTHR; static_assert(BATCH * NCOLS % NTHR == 0, "load_mod");
    float v[NIT][4];
#pragma unroll
    for (int j = 0; j < NIT; ++j) { const int i = tid + j * NTHR, b = i / NCOLS, c = i % NCOLS;
#pragma unroll
        for (int kq = 0; kq < 4; ++kq) v[j][kq] = part[(size_t)(kq * 4 + b) * MODW + col0 + c]; }
#pragma unroll
    for (int j = 0; j < NIT; ++j) dst[tid + j * NTHR] = (v[j][0] + v[j][1]) + (v[j][2] + v[j][3]);
}

__device__ __forceinline__ void p1_ln_pass(LAS unsigned char* lds, const float* const* in, unsigned char* ws, int tid, int lane, int wave, int G) {
    LAS float* modL = (LAS float*)lds;
    LAS float* wfL = (LAS float*)(lds + 32768);
    const float* part = (const float*)(ws + WS_PART);
    load_mod<2048>(modL, part, 0, tid);
#pragma unroll
    for (int it_ = 0; it_ < D * 2 / NTHR; ++it_) { const int i = tid + it_ * NTHR; const int d = i >> 1, hf = i & 1; const f32x4 w4 = *(const GAS f32x4*)(in[4] + (size_t)d * WIN_LD + OFF_F + hf * 4);
        wfL[(hf * 4 + 0) * D + d] = w4.x; wfL[(hf * 4 + 1) * D + d] = w4.y; wfL[(hf * 4 + 2) * D + d] = w4.z; wfL[(hf * 4 + 3) * D + d] = w4.w; }
    __syncthreads();
    const float* x = in[0]; const float* b_f = in[5];
    bf16* U = (bf16*)(ws + WS_R1); float* logf = (float*)(ws + WS_LOGF);
    const int gw = (int)blockIdx.x * NWAVES + wave, NGW = G * NWAVES;
    f32x4 nx[4];
    if (gw < M) {
#pragma unroll
        for (int j = 0; j < 4; ++j) nx[j] = ((const GAS f32x4*)(x + (size_t)gw * D) + lane)[64 * j]; }
    for (int m = gw; m < M; m += NGW) {
        const int b = m / SEQ;
        f32x4 v[4]; float s = 0.f;
#pragma unroll
        for (int j = 0; j < 4; ++j) { v[j] = nx[j]; s += (v[j].x + v[j].y) + (v[j].z + v[j].w); }
        { const int mn = (m + NGW < M) ? m + NGW : m; const GAS f32x4* xr = (const GAS f32x4*)(x + (size_t)mn * D) + lane;
#pragma unroll
          for (int j = 0; j < 4; ++j) nx[j] = xr[64 * j]; }
        const float mean = wave_sum(s) * (1.f / D); float s2 = 0.f;
#pragma unroll
        for (int j = 0; j < 4; ++j) { v[j] = v[j] - mean; s2 += (v[j].x * v[j].x + v[j].y * v[j].y) + (v[j].z * v[j].z + v[j].w * v[j].w); }
        const float rstd = 1.f / sqrtf(wave_sum(s2) * (1.f / D) + LN_EPS);
        float f[8];
#pragma unroll
        for (int h = 0; h < 8; ++h) f[h] = 0.f;
        GAS unsigned long long* o8 = (GAS unsigned long long*)(U + (size_t)m * D) + lane;
#pragma unroll
        for (int j = 0; j < 4; ++j) { const int d0 = 256 * j + 4 * lane;
            const f32x4 sh = *(const LAS f32x4*)(modL + b * 2048 + d0), sc = *(const LAS f32x4*)(modL + b * 2048 + 1024 + d0);
            f32x4 u = v[j] * rstd * (sc + 1.0f) + sh;
            o8[64 * j] = (unsigned long long)pk2(u.x, u.y) | ((unsigned long long)pk2(u.z, u.w) << 32);
#pragma unroll
            for (int h = 0; h < 8; ++h) { const f32x4 w4 = *(const LAS f32x4*)(wfL + h * D + d0); f[h] += (u.x * w4.x + u.y * w4.y) + (u.z * w4.z + u.w * w4.w); } }
#pragma unroll
        for (int h = 0; h < 8; ++h) f[h] = wave_sum(f[h]);
        float fz = f[0];
#pragma unroll
        for (int h = 1; h < 8; ++h) fz = (lane == h) ? f[h] : fz;
        if (lane < 8) { const float z = fz + b_f[lane]; logf[(size_t)m * 8 + lane] = fminf(z, 0.f) - log1pf(expf(-fabsf(z))); }
    }
}

__device__ __forceinline__ void p2_scan(LAS unsigned char* lds, unsigned char* ws, int bh, int tid, int lane, int wave) {
    LAS float* tot = (LAS float*)lds;
    const float* logf = (const float*)(ws + WS_LOGF); float* FB = (float*)(ws + WS_FB);
    const int b = bh >> 3, h = bh & 7;
    float v[8]; float run = 0.f;
#pragma unroll
    for (int k = 0; k < 8; ++k) { run += logf[((size_t)b * SEQ + 8 * tid + k) * 8 + h]; v[k] = run; }
    float inc = run;
#pragma unroll
    for (int o = 1; o < 64; o <<= 1) { const float t = __shfl_up(inc, o); if (lane >= o) inc += t; }
    if (lane == 63) tot[wave] = inc;
    __syncthreads();
    float base = inc - run;
    for (int w = 0; w < wave; ++w) base += tot[w];
#pragma unroll
    for (int k = 0; k < 8; ++k) FB[(size_t)bh * SEQ + 8 * tid + k] = (base + v[k]) * LOG2E;
    __syncthreads();
}

__device__ __forceinline__ void p3_conv_unit(LAS unsigned char* lds, const float* const* in, unsigned char* ws, int unit, int tid, int lane, int wave) {
    LAS bf16* gt = (LAS bf16*)lds; LAS float* ct = (LAS float*)(lds + 63488);
    const bf16* Gm = (const bf16*)(ws + WS_G); bf16* HC = (bf16*)(ws + WS_HC);
    const int m0 = unit * 32, s0 = m0 % SEQ;
    __syncthreads();
    { v4u w[8];
#pragma unroll
      for (int it = 0; it < 8; ++it) { const int i = tid + it * NTHR, r = i >> 6, c8 = i & 63; w[it] = (v4u){0u, 0u, 0u, 0u};
          if (i < 62 * 64 && (r >= 30 || s0 != 0)) w[it] = *(const GAS v4u*)(Gm + (size_t)(m0 - 30 + r) * CC + 8 * c8); }
#pragma unroll
      for (int it = 0; it < 8; ++it) { const int i = tid + it * NTHR, r = i >> 6, c8 = i & 63; if (i < 62 * 64) *(LAS v4u*)(gt + r * 512 + 8 * c8) = w[it]; } }
    float w[CK];
#pragma unroll
    for (int k = 0; k < CK; ++k) w[k] = in[6][k * CC + tid];
    const float cb = in[7][tid];
    __syncthreads();
#pragma unroll 1
    for (int g8 = 0; g8 < 4; ++g8) {
        float acc[8];
#pragma unroll
        for (int t = 0; t < 8; ++t) acc[t] = cb;
#pragma unroll
        for (int r = 0; r < 38; ++r) { const float gv = __uint_as_float((unsigned)gt[(g8 * 8 + r) * 512 + tid] << 16);
#pragma unroll
            for (int t = 0; t < 8; ++t) { const int k = r - t; if (k >= 0 && k < CK) acc[t] += w[k] * gv; } }
#pragma unroll
        for (int t = 0; t < 8; ++t) ct[(g8 * 8 + t) * 512 + tid] = acc[t];
    }
    __syncthreads();
    const float* lg = in[8]; const float* lb = in[9];
    const f32x4 g0 = *(const GAS f32x4*)(lg + 8 * lane), g1 = *(const GAS f32x4*)(lg + 8 * lane + 4), b0 = *(const GAS f32x4*)(lb + 8 * lane), b1 = *(const GAS f32x4*)(lb + 8 * lane + 4);
#pragma unroll 1
    for (int t = 0; t < 4; ++t) { const int tok = wave * 4 + t;
        const f32x4 a0 = *(const LAS f32x4*)(ct + tok * 512 + 8 * lane), a1 = *(const LAS f32x4*)(ct + tok * 512 + 8 * lane + 4);
        const float mean = wave_sum((a0.x + a0.y) + (a0.z + a0.w) + (a1.x + a1.y) + (a1.z + a1.w)) * (1.f / CC);
        const f32x4 d0 = a0 - mean, d1 = a1 - mean;
        const float var = wave_sum((d0.x * d0.x + d0.y * d0.y) + (d0.z * d0.z + d0.w * d0.w) + (d1.x * d1.x + d1.y * d1.y) + (d1.z * d1.z + d1.w * d1.w)) * (1.f / CC);
        const float rstd = 1.f / sqrtf(var + LN_EPS);
        f32x4 y0 = d0 * rstd * g0 + b0, y1 = d1 * rstd * g1 + b1;
#pragma unroll
        for (int e = 0; e < 4; ++e) { y0[e] = y0[e] / (1.0f + __expf(-y0[e])); y1[e] = y1[e] / (1.0f + __expf(-y1[e])); }
        v4u o; o.x = pk2(y0.x, y0.y); o.y = pk2(y0.z, y0.w); o.z = pk2(y1.x, y1.y); o.w = pk2(y1.z, y1.w);
        *(GAS v4u*)(HC + (size_t)(m0 + tok) * CC + 8 * lane) = o; }
}

__device__ __forceinline__ void p6_ln_pass(LAS unsigned char* lds, const float* const* in, float* out, unsigned char* ws, int tid, int lane, int wave, int G) {
    LAS float* modL = (LAS float*)lds;
    load_mod<3072>(modL, (const float*)(ws + WS_PART), 2048, tid);
    __syncthreads();
    const float* x = in[0]; const bf16* outf = (const bf16*)(ws + WS_OUTF); const float* lg = in[13]; const float* lb = in[14];
    bf16* U2 = (bf16*)(ws + WS_R1);
    const int gw = (int)blockIdx.x * NWAVES + wave, NGW = G * NWAVES;
    f32x4 lgv[4], lbv[4];
#pragma unroll
    for (int j = 0; j < 4; ++j) { lgv[j] = *(const GAS f32x4*)(lg + 256 * j + 4 * lane); lbv[j] = *(const GAS f32x4*)(lb + 256 * j + 4 * lane); }
    f32x4 nx[4]; unsigned long long no[4];
    if (gw < M) {
#pragma unroll
        for (int j = 0; j < 4; ++j) { nx[j] = ((const GAS f32x4*)(x + (size_t)gw * D) + lane)[64 * j]; no[j] = ((const GAS unsigned long long*)(outf + (size_t)gw * D) + lane)[64 * j]; } }
    for (int m = gw; m < M; m += NGW) {
        const int b = m / SEQ;
        f32x4 v[4]; float s = 0.f;
#pragma unroll
        for (int j = 0; j < 4; ++j) { const f32x4 g1 = *(const LAS f32x4*)(modL + b * 3072 + 256 * j + 4 * lane);
            const unsigned long long ow = no[j]; const unsigned olo = (unsigned)ow, ohi = (unsigned)(ow >> 32); const f32x4 ov = (f32x4){bf_lo(olo), bf_hi(olo), bf_lo(ohi), bf_hi(ohi)};
            v[j] = nx[j] * ALPHA + (g1 + 1.0f) * ov; s += (v[j].x + v[j].y) + (v[j].z + v[j].w); }
        { const int mn = (m + NGW < M) ? m + NGW : m; const GAS f32x4* xr = (const GAS f32x4*)(x + (size_t)mn * D) + lane; const GAS unsigned long long* orr = (const GAS unsigned long long*)(outf + (size_t)mn * D) + lane;
#pragma unroll
          for (int j = 0; j < 4; ++j) { nx[j] = xr[64 * j]; no[j] = orr[64 * j]; } }
        float mean = wave_sum(s) * (1.f / D); float s2 = 0.f;
#pragma unroll
        for (int j = 0; j < 4; ++j) { v[j] = v[j] - mean; s2 += (v[j].x * v[j].x + v[j].y * v[j].y) + (v[j].z * v[j].z + v[j].w * v[j].w); }
        float rstd = 1.f / sqrtf(wave_sum(s2) * (1.f / D) + LN_EPS);
        s = 0.f;
        GAS f32x4* x1r = (GAS f32x4*)(out + (size_t)m * D) + lane;
#pragma unroll
        for (int j = 0; j < 4; ++j) { const f32x4 gg = lgv[j], bb = lbv[j];
            v[j] = v[j] * rstd * gg + bb; x1r[64 * j] = v[j]; s += (v[j].x + v[j].y) + (v[j].z + v[j].w); }
        mean = wave_sum(s) * (1.f / D); s2 = 0.f;
#pragma unroll
        for (int j = 0; j < 4; ++j) { v[j] = v[j] - mean; s2 += (v[j].x * v[j].x + v[j].y * v[j].y) + (v[j].z * v[j].z + v[j].w * v[j].w); }
        rstd = 1.f / sqrtf(wave_sum(s2) * (1.f / D) + LN_EPS);
        GAS unsigned long long* o8 = (GAS unsigned long long*)(U2 + (size_t)m * D) + lane; float am = 0.f;
#pragma unroll
        for (int j = 0; j < 4; ++j) { const f32x4 sh = *(const LAS f32x4*)(modL + b * 3072 + 1024 + 256 * j + 4 * lane), sc = *(const LAS f32x4*)(modL + b * 3072 + 2048 + 256 * j + 4 * lane);
            const f32x4 u = v[j] * rstd * (sc + 1.0f) + sh; v[j] = u;
            am = fmaxf(am, fmaxf(fmaxf(fabsf(u.x), fabsf(u.y)), fmaxf(fabsf(u.z), fabsf(u.w))));
            o8[64 * j] = (unsigned long long)pk2(u.x, u.y) | ((unsigned long long)pk2(u.z, u.w) << 32); }
        am = wave_max(am);
        const float inv = am > 0.f ? 127.0f / am : 0.f;
        GAS unsigned* x8 = (GAS unsigned*)(ws + WS_X8 + (size_t)m * D) + lane;
#pragma unroll
        for (int j = 0; j < 4; ++j) { const int q0 = (int)rintf(v[j].x * inv), q1 = (int)rintf(v[j].y * inv), q2 = (int)rintf(v[j].z * inv), q3 = (int)rintf(v[j].w * inv);
            x8[64 * j] = (unsigned)(q0 & 255) | ((unsigned)(q1 & 255) << 8) | ((unsigned)(q2 & 255) << 16) | ((unsigned)(q3 & 255) << 24); }
        if (lane == 0) ((float*)(ws + WS_SX))[m] = am * (1.0f / 127.0f);
    }
}

#define CE_D(a, b) do { const float hi_ = fmaxf((a), (b)), lo_ = fminf((a), (b)); (a) = hi_; (b) = lo_; } while (0)
template <int OFF> __device__ __forceinline__ void sort16_desc(float (&v)[64]) {
    constexpr int NET[63][2] = {{0,1},{2,3},{0,2},{1,3},{1,2},{4,5},{6,7},{4,6},{5,7},{5,6},{0,4},{2,6},{2,4},{1,5},{3,7},{3,5},{1,2},{3,4},{5,6},{8,9},{10,11},{8,10},{9,11},{9,10},{12,13},{14,15},{12,14},{13,15},{13,14},{8,12},{10,14},{10,12},{9,13},{11,15},{11,13},{9,10},{11,12},{13,14},{0,8},{4,12},{4,8},{2,10},{6,14},{6,10},{2,4},{6,8},{10,12},{1,9},{5,13},{5,9},{3,11},{7,15},{7,11},{3,5},{7,9},{11,13},{1,2},{3,4},{5,6},{7,8},{9,10},{11,12},{13,14}};
#pragma unroll
    for (int i = 0; i < 63; ++i) CE_D(v[OFF + NET[i][0]], v[OFF + NET[i][1]]);
}
__device__ __forceinline__ void merge16_desc(float (&a)[16]) {
#pragma unroll
    for (int j = 8; j > 0; j >>= 1)
#pragma unroll
        for (int i = 0; i < 16; ++i) { const int l = i ^ j; if (l > i) CE_D(a[i], a[l]); }
}
__device__ __forceinline__ void mergetrunc16(float (&a)[16], const float (&b)[16]) {
#pragma unroll
    for (int i = 0; i < 16; ++i) a[i] = fmaxf(a[i], b[15 - i]);
    merge16_desc(a);
}
__device__ __forceinline__ float tagf(float x, unsigned mask, unsigned tag) { return __uint_as_float((__float_as_uint(x) & ~mask) | tag); }
typedef float f32x16_t __attribute__((ext_vector_type(16)));
constexpr int KROW = 72;
constexpr int P8_KH = 0, P8_KL = 2 * NKEYS * KROW * 2, P8_IDX = 2 * P8_KL;
__device__ __forceinline__ bf16x8 split_hi8(const f32x4& a, const f32x4& b, f32x4& ra, f32x4& rb) {
    bf16x8 o;
#pragma unroll
    for (int e = 0; e < 4; ++e) { const unsigned ha = f2bf(a[e]), hb = f2bf(b[e]); o[e] = (short)ha; o[4 + e] = (short)hb; ra[e] = a[e] - __uint_as_float(ha << 16); rb[e] = b[e] - __uint_as_float(hb << 16); }
    return o;
}
template <class Sched> __device__ __forceinline__ void p8_topk(LAS unsigned char* lds, const float* const* in, unsigned char* ws, int tid, int lane, int wave, const Sched& S) {
#pragma unroll
    for (int it_ = 0; it_ < 2 * NKEYS * PDH / 4 / NTHR; ++it_) { const int i = tid + it_ * NTHR; const f32x4 k4 = *(const GAS f32x4*)(in[16] + 4 * i); const int row = i >> 4, c4 = (i & 15) * 4;
        unsigned h[4], l[4];
#pragma unroll
        for (int e = 0; e < 4; ++e) { h[e] = f2bf(k4[e]); l[e] = f2bf(k4[e] - __uint_as_float(h[e] << 16)); }
        *(LAS unsigned long long*)(lds + P8_KH + (row * KROW + c4) * 2) = (unsigned long long)(h[0] | (h[1] << 16)) | ((unsigned long long)(h[2] | (h[3] << 16)) << 32);
        *(LAS unsigned long long*)(lds + P8_KL + (row * KROW + c4) * 2) = (unsigned long long)(l[0] | (l[1] << 16)) | ((unsigned long long)(l[2] | (l[3] << 16)) << 32); }
    __syncthreads();
    const float* QP = (const float*)(ws + WS_QP); unsigned short* IDX = (unsigned short*)(ws + WS_IDX); float* GATE = (float*)(ws + WS_GATE);
    const int j = lane & 31, hi = lane >> 5;
    LAS unsigned char* ib = lds + P8_IDX + wave * 2048 + lane;
    pg8::Unit un;
#pragma unroll 1
    for (int ui = 0; S.next(ui, un); ++ui) {
        const int t0 = un.pm * 256 + 32 * wave, hp = un.pn;
        float L0[16], sv0[16], sv1[16];
#pragma unroll
        for (int i = 0; i < 16; ++i) { L0[i] = 0.f; sv0[i] = 0.f; sv1[i] = 0.f; }
#pragma unroll 1
        for (int inst = 0; inst < 4; ++inst) {
            const int hh = inst >> 1, p = inst & 1;
            bf16x8 qh[4], ql[4];
            { const float* qrow = QP + (size_t)(t0 + j) * D + (2 * hp + hh) * 128 + p * 64 + 8 * hi;
#pragma unroll
              for (int ks = 0; ks < 4; ++ks) { const f32x4 a = *(const GAS f32x4*)(qrow + 16 * ks), b = *(const GAS f32x4*)(qrow + 16 * ks + 4); f32x4 ra, rb, r2a, r2b;
                  qh[ks] = split_hi8(a, b, ra, rb); ql[ks] = split_hi8(ra, rb, r2a, r2b); } }
            f32x16_t acc[4];
            const int koff = ((p * NKEYS + j) * KROW + 8 * hi) * 2;
#pragma unroll
            for (int kb = 0; kb < 4; ++kb) {
                acc[kb] = (f32x16_t){0.f, 0.f, 0.f, 0.f, 0.f, 0.f, 0.f, 0.f, 0.f, 0.f, 0.f, 0.f, 0.f, 0.f, 0.f, 0.f};
#pragma unroll
                for (int ks = 0; ks < 4; ++ks) { const int off = koff + (32 * kb * KROW + 16 * ks) * 2;
                    const bf16x8 kh = *(const LAS bf16x8*)(lds + P8_KH + off), kl = *(const LAS bf16x8*)(lds + P8_KL + off);
                    acc[kb] = __builtin_amdgcn_mfma_f32_32x32x16_bf16(kh, qh[ks], acc[kb], 0, 0, 0);
                    acc[kb] = __builtin_amdgcn_mfma_f32_32x32x16_bf16(kh, ql[ks], acc[kb], 0, 0, 0);
                    acc[kb] = __builtin_amdgcn_mfma_f32_32x32x16_bf16(kl, qh[ks], acc[kb], 0, 0, 0); }
            }
            float v[64];
#pragma unroll
            for (int kb = 0; kb < 4; ++kb)
#pragma unroll
                for (int r = 0; r < 16; ++r) v[16 * kb + r] = tagf(acc[kb][r], 127u, 127u - (unsigned)(32 * kb + (r & 3) + 8 * (r >> 2)));
            sort16_desc<0>(v); sort16_desc<16>(v); sort16_desc<32>(v); sort16_desc<48>(v);
            float a0[16], a1[16], a2[16], a3[16];
#pragma unroll
            for (int i = 0; i < 16; ++i) { a0[i] = v[i]; a1[i] = v[16 + i]; a2[i] = v[32 + i]; a3[i] = v[48 + i]; }
            mergetrunc16(a0, a1); mergetrunc16(a2, a3); mergetrunc16(a0, a2);
#pragma unroll
            for (int i = 0; i < 16; ++i) a0[i] = __uint_as_float(__float_as_uint(a0[i]) & ~((unsigned)hi << 2));
            if (p == 0) {
#pragma unroll
                for (int i = 0; i < 16; ++i) L0[i] = a0[i];
            } else {
                float X[16], Y[16];
#pragma unroll
                for (int i = 0; i < 16; ++i) { const auto rr = __builtin_amdgcn_permlane32_swap(__float_as_uint(L0[i]), __float_as_uint(a0[i]), false, false); X[i] = __uint_as_float(rr[0]); Y[i] = __uint_as_float(rr[1]); }
                mergetrunc16(X, Y);
#pragma unroll
                for (int i = 0; i < 16; ++i) { const auto rr = __builtin_amdgcn_permlane32_swap(__float_as_uint(X[i]), __float_as_uint(X[i]), false, false);
                    sv0[i] = (hi == hh) ? __uint_as_float(rr[0]) : sv0[i]; sv1[i] = (hi == hh) ? __uint_as_float(rr[1]) : sv1[i]; }
            }
        }
        const int head = 2 * hp + hi;
#pragma unroll
        for (int i = 0; i < 16; ++i) { ib[i * 64] = (unsigned char)(127u - (__float_as_uint(sv0[i]) & 127u)); ib[(16 + i) * 64] = (unsigned char)(127u - (__float_as_uint(sv1[i]) & 127u)); }
#define CAND(a, b) tagf(sv0[a] + sv1[b], 255u, 255u - (unsigned)((a) * 16 + (b)))
        float T[16], U1[16];
#pragma unroll
        for (int b = 0; b < 16; ++b) T[b] = CAND(0, b);
#pragma unroll
        for (int b = 0; b < 8; ++b) { U1[b] = CAND(1, b); U1[8 + b] = CAND(15 - b, 0); }
        merge16_desc(U1);
        mergetrunc16(T, U1);
#pragma unroll
        for (int a = 2; a < 8; ++a)
#pragma unroll
            for (int b = 0; b < 16; ++b) if ((a + 1) * (b + 1) <= 16) { float x = CAND(a, b);
#pragma unroll
                for (int i = (a + 1) * (b + 1) - 1; i < 16; ++i) CE_D(T[i], x); }
#undef CAND
        float e[16]; float sum = 0.f;
#pragma unroll
        for (int i = 0; i < 16; ++i) { e[i] = __expf(T[i] - T[0]); sum += e[i]; }
        const float rs = 1.0f / sum;
        LDS_WAIT(); asm volatile("" ::: "memory");
        int ce[16];
#pragma unroll
        for (int i = 0; i < 16; ++i) { const unsigned id = 255u - (__float_as_uint(T[i]) & 255u); ce[i] = (int)ib[(id >> 4) * 64] * NKEYS + (int)ib[(16 + (id & 15u)) * 64]; }
        const size_t o = (size_t)(t0 + j) * NSEL + head * 16;
#pragma unroll
        for (int i = 0; i < 16; i += 8) *(GAS v4u*)(IDX + o + i) = (v4u){(unsigned)ce[i] | ((unsigned)ce[i + 1] << 16), (unsigned)ce[i + 2] | ((unsigned)ce[i + 3] << 16), (unsigned)ce[i + 4] | ((unsigned)ce[i + 5] << 16), (unsigned)ce[i + 6] | ((unsigned)ce[i + 7] << 16)};
#pragma unroll
        for (int i = 0; i < 16; i += 4) {
            *(GAS f32x4*)(GATE + o + i) = (f32x4){e[i] * rs, e[i + 1] * rs, e[i + 2] * rs, e[i + 3] * rs}; }
        LDS_WAIT(); asm volatile("" ::: "memory");
    }
}

typedef int v4i __attribute__((ext_vector_type(4)));
__device__ __forceinline__ float gelu_tanh(float a) { const float y = 0.7978845608028654f * (a + 0.044715f * a * a * a); const float t = 1.0f - 2.0f / (1.0f + __expf(2.0f * y)); return 0.5f * a * (1.0f + t); }
struct G1Item { v4i row[16]; v4i x; };
struct GMeta { unsigned mi; v4i mv; };
__device__ __forceinline__ void g_meta_load(const unsigned* IDXd, const unsigned char* side, int side_pitch, int nside, int t, int lane, GMeta& m) {
    m.mi = IDXd[(size_t)t * (NSEL / 2) + lane];
    if (lane < nside) m.mv = *(const GAS v4i*)(side + (size_t)t * side_pitch + 16 * lane);
}
__device__ __forceinline__ void g_meta_lds(LAS unsigned char* wl, const GMeta& m, int nside, int lane, int rr, int (&e)[16]) {
    ((LAS unsigned*)wl)[lane] = m.mi;
    if (lane < nside) *(LAS v4i*)(wl + 256 + 16 * lane) = m.mv;
    asm volatile("s_waitcnt lgkmcnt(0)" ::: "memory");
#pragma unroll
    for (int q = 0; q < 2; ++q) { const v4u ev = *(const LAS v4u*)(wl + 32 * rr + 16 * q);
#pragma unroll
        for (int j = 0; j < 4; ++j) { e[8 * q + 2 * j] = (int)(ev[j] & 0xffffu); e[8 * q + 2 * j + 1] = (int)(ev[j] >> 16); } }
}
__device__ __forceinline__ void g1_rows(const unsigned char* U8, const int (&e)[16], G1Item& it) {
#pragma unroll
    for (int i = 0; i < 16; ++i) it.row[i] = *(const GAS v4i*)(U8 + (size_t)e[i] * D);
}
__device__ __forceinline__ void g1_compute(const G1Item& it, int* AP, int t, int rr, int c) {
    int p[16];
#pragma unroll
    for (int i = 0; i < 16; ++i) { int a = __builtin_amdgcn_sdot4(it.row[i].x, it.x.x, 0, false); a = __builtin_amdgcn_sdot4(it.row[i].y, it.x.y, a, false); a = __builtin_amdgcn_sdot4(it.row[i].z, it.x.z, a, false); p[i] = __builtin_amdgcn_sdot4(it.row[i].w, it.x.w, a, false); }
    int q8[8], q4[4], q2[2];
    { const bool up = (c >> 2) & 1;
#pragma unroll
      for (int j = 0; j < 8; ++j) { const int keep = up ? p[8 + j] : p[j], send = up ? p[j] : p[8 + j]; q8[j] = keep + dppi<0x141>(send); } }
    { const bool up = c & 1;
#pragma unroll
      for (int j = 0; j < 4; ++j) { const int keep = up ? q8[4 + j] : q8[j], send = up ? q8[j] : q8[4 + j]; q4[j] = keep + dppi<0xB1>(send); } }
    { const bool up = (c >> 1) & 1;
#pragma unroll
      for (int j = 0; j < 2; ++j) { const int keep = up ? q4[2 + j] : q4[j], send = up ? q4[j] : q4[2 + j]; q2[j] = keep + dppi<0x4E>(send); } }
    const int i0 = 8 * ((c >> 2) & 1) + 4 * (c & 1) + 2 * ((c >> 1) & 1);
    typedef int v2i __attribute__((ext_vector_type(2)));
    *(GAS v2i*)(AP + (size_t)t * NSEL + 16 * rr + i0) = (v2i){q2[0], q2[1]};
}
__device__ __forceinline__ void p9_g1(LAS unsigned char* lds, unsigned char* ws, int lane, int wave, int sl, int tb, int ntb) {
    const int rr = lane >> 3, c = lane & 7;
    const unsigned* IDXd = (const unsigned*)(ws + WS_IDX); const unsigned char* U8 = ws + WS_U8 + 128 * sl + 16 * c; const unsigned char* X8s = ws + WS_X8 + 128 * sl;
    int* AP = (int*)(ws + WS_APART) + (size_t)sl * M * NSEL;
    LAS unsigned char* wl = lds + wave * 512;
    const int tstep = ntb * NWAVES, tfirst = tb * NWAVES + wave;
    if (tfirst >= M) return;
#define TCL(t) ((t) < M ? (t) : tfirst)
    G1Item A, B; GMeta mA, mB; int e[16];
    g_meta_load(IDXd, X8s, D, 8, tfirst, lane, mA); g_meta_lds(wl, mA, 8, lane, rr, e); A.x = *(const LAS v4i*)(wl + 256 + 16 * c); g1_rows(U8, e, A);
    g_meta_load(IDXd, X8s, D, 8, TCL(tfirst + tstep), lane, mB);
#pragma unroll 1
    for (int t = tfirst; t < M; t += 2 * tstep) {
        g_meta_load(IDXd, X8s, D, 8, TCL(t + 2 * tstep), lane, mA); g_meta_lds(wl, mB, 8, lane, rr, e); B.x = *(const LAS v4i*)(wl + 256 + 16 * c); g1_rows(U8, e, B);
        g1_compute(A, AP, t, rr, c);
        g_meta_load(IDXd, X8s, D, 8, TCL(t + 3 * tstep), lane, mB); g_meta_lds(wl, mA, 8, lane, rr, e); A.x = *(const LAS v4i*)(wl + 256 + 16 * c); g1_rows(U8, e, A);
        if (t + tstep < M) g1_compute(B, AP, t + tstep, rr, c);
    }
#undef TCL
}
__device__ __forceinline__ void p10_w(unsigned char* ws, int lane, int wave, int G) {
    const unsigned short* IDX = (const unsigned short*)(ws + WS_IDX); const float* GATE = (const float*)(ws + WS_GATE); const int* AP = (const int*)(ws + WS_APART);
    const float* SU = (const float*)(ws + WS_SU); const float* SV = (const float*)(ws + WS_SV); const float* SX = (const float*)(ws + WS_SX);
    unsigned char* W8 = ws + WS_W8;
    const int gw = (int)blockIdx.x * NWAVES + wave, NGW = G * NWAVES;
    if (gw >= M) return;
    typedef int v2i_t __attribute__((ext_vector_type(2))); typedef float v2f_t __attribute__((ext_vector_type(2)));
    unsigned ep; v2i_t ap[8]; v2f_t gt; float sx;
#define W_LOAD1(t) do { ep = ((const unsigned*)IDX)[(size_t)(t) * (NSEL / 2) + lane]; gt = *(const GAS v2f_t*)(GATE + (size_t)(t) * NSEL + 2 * lane); sx = SX[t]; \
        _Pragma("unroll") for (int s = 0; s < 8; ++s) ap[s] = *(const GAS v2i_t*)(AP + ((size_t)s * M + (t)) * NSEL + 2 * lane); } while (0)
    W_LOAD1(gw);
    for (int t = gw; t < M; t += NGW) {
        const int e0 = (int)(ep & 0xffffu), e1 = (int)(ep >> 16);
        const float su0 = SU[e0], su1 = SU[e1], sv0 = SV[e0], sv1 = SV[e1];
        int s0 = 0, s1 = 0;
#pragma unroll
        for (int s = 0; s < 8; ++s) { s0 += ap[s].x; s1 += ap[s].y; }
        const float a0 = (float)s0 * sx * su0, a1 = (float)s1 * sx * su1, gg0 = gt.x, gg1 = gt.y;
        { const int tn = (t + NGW < M) ? t + NGW : t; W_LOAD1(tn); }
        const float w0 = gelu_tanh(a0) * gg0 * sv0, w1 = gelu_tanh(a1) * gg1 * sv1;
        float am = wave_max(fmaxf(fabsf(w0), fabsf(w1)));
        const float inv = am > 0.f ? 127.0f / am : 0.f;
        *(GAS unsigned short*)(W8 + (size_t)t * W8P + 2 * lane) = (unsigned short)(((unsigned)((int)rintf(w0 * inv) & 255)) | (((unsigned)((int)rintf(w1 * inv) & 255)) << 8));
        if (lane == 0) *(float*)(W8 + (size_t)t * W8P + NSEL) = am * (1.0f / 127.0f);
    }
#undef W_LOAD1
}
struct G2Item { v4u row[16]; v4i w8; float wsc; };
__device__ __forceinline__ void g2_rows(const unsigned char* V8, const int (&e)[16], G2Item& it) {
#pragma unroll
    for (int i = 0; i < 16; ++i) it.row[i] = *(const GAS v4u*)(V8 + (size_t)e[i] * D);
}
__device__ __forceinline__ void g2_compute(const G2Item& it, bf16* YP, int t, int sl, int rr, int c, int lane) {
    int acc[16];
#pragma unroll
    for (int i = 0; i < 16; ++i) acc[i] = 0;
#pragma unroll
    for (int g = 0; g < 4; ++g)
#pragma unroll
        for (int q = 0; q < 4; ++q) { const unsigned r0 = it.row[4 * g][q], r1 = it.row[4 * g + 1][q], r2 = it.row[4 * g + 2][q], r3 = it.row[4 * g + 3][q];
            const unsigned a = __builtin_amdgcn_perm(r1, r0, 0x05010400u), b = __builtin_amdgcn_perm(r1, r0, 0x07030602u), cc = __builtin_amdgcn_perm(r3, r2, 0x05010400u), d = __builtin_amdgcn_perm(r3, r2, 0x07030602u);
            const unsigned c0 = __builtin_amdgcn_perm(cc, a, 0x05040100u), c1 = __builtin_amdgcn_perm(cc, a, 0x07060302u), c2 = __builtin_amdgcn_perm(d, b, 0x05040100u), c3 = __builtin_amdgcn_perm(d, b, 0x07060302u);
            const int w4 = it.w8[g];
            acc[4 * q] = __builtin_amdgcn_sdot4((int)c0, w4, acc[4 * q], false); acc[4 * q + 1] = __builtin_amdgcn_sdot4((int)c1, w4, acc[4 * q + 1], false);
            acc[4 * q + 2] = __builtin_amdgcn_sdot4((int)c2, w4, acc[4 * q + 2], false); acc[4 * q + 3] = __builtin_amdgcn_sdot4((int)c3, w4, acc[4 * q + 3], false); }
    int q8[8], q4[4], q2[2];
    { const bool up = rr & 1;
#pragma unroll
      for (int j = 0; j < 8; ++j) { const int keep = up ? acc[8 + j] : acc[j], send = up ? acc[j] : acc[8 + j]; q8[j] = keep + dppi<0x128>(send); } }
    { const bool up = (rr >> 1) & 1;
#pragma unroll
      for (int j = 0; j < 4; ++j) { const int keep = up ? q8[4 + j] : q8[j], send = up ? q8[j] : q8[4 + j]; q4[j] = keep + xlane16(send, lane); } }
    { const bool up = (rr >> 2) & 1;
#pragma unroll
      for (int j = 0; j < 2; ++j) { const int keep = up ? q4[2 + j] : q4[j], send = up ? q4[j] : q4[2 + j]; q2[j] = keep + xlane32(send, lane); } }
    const int i0 = 8 * (rr & 1) + 4 * ((rr >> 1) & 1) + 2 * ((rr >> 2) & 1);
    *(GAS unsigned*)(YP + (size_t)t * D + 128 * sl + 16 * c + i0) = pk2((float)q2[0] * it.wsc, (float)q2[1] * it.wsc);
}
__device__ __forceinline__ void p11_g2(LAS unsigned char* lds, unsigned char* ws, int lane, int wave, int sl, int tb, int ntb) {
    const int rr = lane >> 3, c = lane & 7;
    const unsigned* IDXd = (const unsigned*)(ws + WS_IDX); const unsigned char* W8 = ws + WS_W8;
    const unsigned char* V8 = ws + WS_V8 + 128 * sl + 16 * c; bf16* YP = (bf16*)(ws + WS_YP);
    LAS unsigned char* wl = lds + wave * 512;
    const int tstep = ntb * NWAVES, tfirst = tb * NWAVES + wave;
    if (tfirst >= M) return;
#define TCL(t) ((t) < M ? (t) : tfirst)
#define G2_SIDE(IT) do { IT.w8 = *(const LAS v4i*)(wl + 256 + 16 * rr); IT.wsc = *(const LAS float*)(wl + 256 + NSEL); } while (0)
    G2Item A, B; GMeta mA, mB; int e[16];
    g_meta_load(IDXd, W8, W8P, 9, tfirst, lane, mA); g_meta_lds(wl, mA, 9, lane, rr, e); G2_SIDE(A); g2_rows(V8, e, A);
    g_meta_load(IDXd, W8, W8P, 9, TCL(tfirst + tstep), lane, mB);
#pragma unroll 1
    for (int t = tfirst; t < M; t += 2 * tstep) {
        g_meta_load(IDXd, W8, W8P, 9, TCL(t + 2 * tstep), lane, mA); g_meta_lds(wl, mB, 9, lane, rr, e); G2_SIDE(B); g2_rows(V8, e, B);
        g2_compute(A, YP, t, sl, rr, c, lane);
        g_meta_load(IDXd, W8, W8P, 9, TCL(t + 3 * tstep), lane, mB); g_meta_lds(wl, mA, 9, lane, rr, e); G2_SIDE(A); g2_rows(V8, e, A);
        if (t + tstep < M) g2_compute(B, YP, t + tstep, sl, rr, c, lane);
    }
#undef G2_SIDE
#undef TCL
}
__device__ __forceinline__ void p12_final(LAS unsigned char* lds, const float* const* in, float* out, unsigned char* ws, int tid, int lane, int wave, int G) {
    LAS float* g2L = (LAS float*)lds;
    load_mod<1024>(g2L, (const float*)(ws + WS_PART), 5120, tid);
    __syncthreads();
    const bf16* YP = (const bf16*)(ws + WS_YP); const float* lg = in[19]; const float* lb = in[20];
    const int gw = (int)blockIdx.x * NWAVES + wave, NGW = G * NWAVES;
    f32x4 lgv[4], lbv[4];
#pragma unroll
    for (int j = 0; j < 4; ++j) { lgv[j] = *(const GAS f32x4*)(lg + 256 * j + 4 * lane); lbv[j] = *(const GAS f32x4*)(lb + 256 * j + 4 * lane); }
    f32x4 nx[4]; unsigned long long ny[4];
    if (gw < M) {
#pragma unroll
        for (int j = 0; j < 4; ++j) { nx[j] = ((const GAS f32x4*)(out + (size_t)gw * D) + lane)[64 * j]; ny[j] = ((const GAS unsigned long long*)(YP + (size_t)gw * D) + lane)[64 * j]; } }
    for (int m = gw; m < M; m += NGW) {
        const int b = m / SEQ;
        GAS f32x4* xr = (GAS f32x4*)(out + (size_t)m * D) + lane; f32x4 v[4]; float s = 0.f;
#pragma unroll
        for (int j = 0; j < 4; ++j) { const f32x4 g2 = *(const LAS f32x4*)(g2L + b * 1024 + 256 * j + 4 * lane); const unsigned long long yw = ny[j]; const unsigned ylo = (unsigned)yw, yhi = (unsigned)(yw >> 32);
            v[j] = nx[j] * ALPHA + (g2 + 1.0f) * (f32x4){bf_lo(ylo), bf_hi(ylo), bf_lo(yhi), bf_hi(yhi)}; s += (v[j].x + v[j].y) + (v[j].z + v[j].w); }
        { const int mn = (m + NGW < M) ? m + NGW : m; const GAS f32x4* xn = (const GAS f32x4*)(out + (size_t)mn * D) + lane; const GAS unsigned long long* yr = (const GAS unsigned long long*)(YP + (size_t)mn * D) + lane;
#pragma unroll
          for (int j = 0; j < 4; ++j) { nx[j] = xn[64 * j]; ny[j] = yr[64 * j]; } }
        const float mean = wave_sum(s) * (1.f / D); float s2 = 0.f;
#pragma unroll
        for (int j = 0; j < 4; ++j) { v[j] = v[j] - mean; s2 += (v[j].x * v[j].x + v[j].y * v[j].y) + (v[j].z * v[j].z + v[j].w * v[j].w); }
        const float rstd = 1.f / sqrtf(wave_sum(s2) * (1.f / D) + LN_EPS);
#pragma unroll
        for (int j = 0; j < 4; ++j) xr[64 * j] = v[j] * rstd * lgv[j] + lbv[j];
    }
}

__device__ __forceinline__ int opaque_i(int v) { asm volatile("" : "+v"(v)); return v; }
constexpr int NPHASE = 13;
struct Args { const float* in[21]; float* out; unsigned char* ws; int ph_lo, ph_hi; };
__global__ void __launch_bounds__(NTHR, 2) fwd(Args args) {
    extern __shared__ __attribute__((aligned(16))) unsigned char lds_raw[];
    LAS unsigned char* lds = (LAS unsigned char*)lds_raw;
    volatile LAS unsigned* MISC = (volatile LAS unsigned*)(lds + MISC_OFF);
    const int tid0 = threadIdx.x, wave = __builtin_amdgcn_readfirstlane(tid0 >> 6), G = gridDim.x;
    unsigned char* ws = args.ws; gu32* ctl = (gu32*)(ws + WS_CTL);
    for (int u = tid0; u < (LDS_BYTES - LDSCTL_OFF) / 4; u += NTHR) ((LAS unsigned*)(lds + LDSCTL_OFF))[u] = 0u;
    __syncthreads();
    const int lo = args.ph_lo, hi = args.ph_hi;
    const bool multi = (hi - lo) > 1;
    XcdBarrier bar; bar.bar = (unsigned*)(ctl + CW_BAR); bar.x = 0; bar.st = nullptr;
    if (multi) bar = xcd_barrier_post((unsigned*)(ctl + CW_BAR), MISC + 8);
    if (multi && tid0 == 0) { const unsigned xc = xb_xcc_id(); MISC[16] = xc; MISC[17] = xb_add((unsigned*)(ctl + CW_RANK + 64 * (xc & 15u)), 1u); }
#ifndef PROBE_PHASE
#define PROBE_PHASE -1
#endif
#define IN(k) (lo <= (k) && (k) < hi)
#define PT const int tid = opaque_i(tid0), lane = tid & 63
#ifndef PROBE_PHASE
#define PROBE_PHASE -1
#endif
#define REP(k) for (int rep_ = 0; rep_ < ((k) == PROBE_PHASE ? 2 : 1); ++rep_)
#define SEAM(k) do { if (IN(k) && IN((k) + 1)) { for (int r_ = 0; r_ < (PROBE_PHASE == 200 ? 3 : 1); ++r_) xcd_barrier(bar); } DELAYP(k); } while (0)
#if PROBE_PHASE >= 300
    unsigned long long tprev_ = rt();
#define DELAYP(k) do { const unsigned long long now_ = rt(); if ((k) == PROBE_PHASE - 300) { while (rt() - now_ < now_ - tprev_) __builtin_amdgcn_s_sleep(8); } tprev_ = rt(); } while (0)
#else
#define DELAYP(k) do { } while (0)
#endif

    if (IN(0)) REP(0) { PT; p0_prologue(lds, args.in, ws, tid, lane, wave, G); }
    SEAM(0);
    if (IN(1)) REP(1) { PT; p1_ln_pass(lds, args.in, ws, tid, lane, wave, G); }
    SEAM(1);
    if (IN(2)) REP(2) {
        pg8::Gemm g{(const bf16*)(ws + WS_R1), (const bf16*)(ws + WS_WIN), M, NIN, D}; pg8::StaticOrder S; S.init(M, NIN, G, (int)blockIdx.x);
        pg8::EpiInproj E{(bf16*)(ws + WS_Q), (bf16*)(ws + WS_G), (bf16*)(ws + WS_SGA), (WS_K - WS_Q) / 2, (WS_SGB - WS_SGA) / 2, QSCALE, (unsigned*)(ctl + CW_AQ + 128)};
        pg8::gemm_phase<pg8::EpiInproj, pg8::StaticOrder, true, true>(lds + RING_OFF, g, S, E);
        __syncthreads();
        PT;
        { const int nwg = (M / 256) * (NIN / 256), first = nwg % G;
          if ((int)blockIdx.x >= first) { volatile LAS unsigned* tk = MISC + 20;
              for (int n = 0; n < 4; ++n) { __syncthreads(); if (tid == 0) *tk = xb_add((unsigned*)(ctl + CW_AQ + 320), 1u); __syncthreads(); const int u = __builtin_amdgcn_readfirstlane((int)*tk); if (u >= TC_TICKETS) break; tc_tables(args.in, ws, u, lane, wave); } } }
        for (int bh = G - 1 - (int)blockIdx.x; bh < BATCH * NH; bh += G) p2_scan(lds, ws, bh, tid, lane, wave);
    }
    SEAM(2);
    if (IN(3)) {
        { static_assert(attn_body::ATTN_LDS_BYTES + 64 <= RING_BYTES && attn_body::ATTN_PITCH == AW, "attention body geometry vs frame");
          const attn_body::AttnTensors AT{(const attn_body::bf16*)(ws + WS_Q), (const attn_body::bf16*)(ws + WS_K), (const attn_body::bf16*)(ws + WS_V), (attn_body::bf16*)(ws + WS_AO), (const float*)(ws + WS_FB)};
          const int vcu = (G % 8 == 0) ? ((int)blockIdx.x % 8) * (G / 8) + (int)blockIdx.x / 8 : (int)blockIdx.x;
          attn_body::attn_phase<8>((char*)lds_raw + RING_OFF, AT, (unsigned*)(ctl + CW_AQ), (unsigned*)(ctl + CW_AQ + 128), vcu, G); }
        __syncthreads();
        { PT; volatile LAS unsigned* tk = MISC + 20;
          for (;;) { __syncthreads(); if (tid == 0) *tk = xb_add((unsigned*)(ctl + CW_AQ + 256), 1u); __syncthreads(); const int u = __builtin_amdgcn_readfirstlane((int)*tk); if (u >= M / 32) break;
              p3_conv_unit(lds, args.in, ws, u, tid, lane, wave); }
          for (;;) { __syncthreads(); if (tid == 0) *tk = xb_add((unsigned*)(ctl + CW_AQ + 320), 1u); __syncthreads(); const int u = __builtin_amdgcn_readfirstlane((int)*tk); if (u >= TC_TICKETS) break; tc_tables(args.in, ws, u, lane, wave); } }
    }
    SEAM(3);
    if (IN(4)) REP(4) {
        pg8::StaticOrder S; S.init(M, D, G, (int)blockIdx.x);
        { pg8::Gemm g{(const bf16*)(ws + WS_AO), (const bf16*)(ws + WS_WA), M, D, AW}; pg8::EpiGate<0> E{(const bf16*)(ws + WS_SGA), (bf16*)(ws + WS_R1)};
          pg8::gemm_phase<pg8::EpiGate<0>, pg8::StaticOrder, true, true>(lds + RING_OFF, g, S, E); }
        __syncthreads();
        { pg8::Gemm g{(const bf16*)(ws + WS_HC), (const bf16*)(ws + WS_WB), M, D, CC}; pg8::EpiGate<1> E{(const bf16*)(ws + WS_SGB), (bf16*)(ws + WS_R1)};
          pg8::gemm_phase<pg8::EpiGate<1>, pg8::StaticOrder, true, true>(lds + RING_OFF, g, S, E); }
    }
    SEAM(4);
    if (IN(5)) REP(5) {
        pg8::Gemm g{(const bf16*)(ws + WS_R1), (const bf16*)(ws + WS_WO), M, D, D}; pg8::StaticOrder S; S.init(M, D, G, (int)blockIdx.x);
        pg8::EpiB16 E{(bf16*)(ws + WS_OUTF), D};
        pg8::gemm_phase<pg8::EpiB16, pg8::StaticOrder, true, true>(lds + RING_OFF, g, S, E);
    }
    SEAM(5);
    if (IN(6)) REP(6) { PT; p6_ln_pass(lds, args.in, args.out, ws, tid, lane, wave, G); }
    SEAM(6);
    if (IN(7)) REP(7) {
        pg8::Gemm g{(const bf16*)(ws + WS_R1), (const bf16*)(ws + WS_WQ), M, D, D}; pg8::StaticOrder S; S.init(M, D, G, (int)blockIdx.x);
        pg8::EpiF32 E{(float*)(ws + WS_QP), D};
        pg8::gemm_phase<pg8::EpiF32, pg8::StaticOrder, true, true>(lds + RING_OFF, g, S, E);
    }
    if (IN(7) && IN(8)) { VM_WAIT(); __syncthreads(); }
    if (IN(8)) REP(8) { PT; pg8::StaticOrder S; S.init(M, D, G, (int)blockIdx.x); p8_topk(lds, args.in, ws, tid, lane, wave, S); }
    SEAM(8);
    int sl = (int)blockIdx.x & 7, tb = (int)blockIdx.x >> 3; const int ntb = G >> 3;
    if (IN(9) || IN(11)) {
        if (multi && lo < 9) {
            if (tid0 == 0) { bool uni = (G & 7) == 0;
                for (int j = 0; j < 16; ++j) { const unsigned c = xb_ld((unsigned*)(ctl + CW_BAR) + XB_XCNT(j)); uni = uni && (c == (j < 8 ? (unsigned)(G >> 3) : 0u)); }
                MISC[18] = uni ? 1u : 0u; }
            __syncthreads();
            if (MISC[18]) { sl = (int)MISC[16]; tb = (int)MISC[17]; }
        }
    }
    if (IN(9)) REP(9) { PT; p9_g1(lds, ws, lane, wave, sl, tb, ntb); }
    SEAM(9);
    if (IN(10)) { PT; p10_w(ws, lane, wave, G); }
    SEAM(10);
    if (IN(11)) REP(11) { PT; p11_g2(lds, ws, lane, wave, sl, tb, ntb); }
    SEAM(11);
    if (IN(12)) { PT; p12_final(lds, args.in, args.out, ws, tid, lane, wave, G); }
    DELAYP(12);
#undef IN
#undef SEAM
}

#ifndef MK_ONE_LAUNCH
#define MK_ONE_LAUNCH 1
#endif
extern "C" void kernel_launch(void* const* d_in, const int* in_sizes, int n_in, void* d_out, int out_size, void* d_ws, size_t ws_size, hipStream_t stream) {
    static int grid = 0;
    if (grid == 0) {
        if (n_in != 21 || out_size != M * D || ws_size < WS_END) { fprintf(stderr, "kernel_launch: unexpected problem shape (n_in %d, out %d, ws %zu)\n", n_in, out_size, ws_size); grid = -1; return; }
        int dev = 0, cus = 0, per_cu = 0;
        if (hipGetDevice(&dev) != hipSuccess || hipDeviceGetAttribute(&cus, hipDeviceAttributeMultiprocessorCount, dev) != hipSuccess) { grid = -1; return; }
        if (hipFuncSetAttribute((const void*)fwd, hipFuncAttributeMaxDynamicSharedMemorySize, LDS_BYTES) != hipSuccess) { fprintf(stderr, "kernel_launch: hipFuncSetAttribute failed\n"); grid = -1; return; }
        if (hipOccupancyMaxActiveBlocksPerMultiprocessor(&per_cu, (const void*)fwd, NTHR, LDS_BYTES) != hipSuccess || per_cu < 1) { fprintf(stderr, "kernel_launch: occupancy query says %d\n", per_cu); }
        (void)hipGetLastError();
        grid = cus;
    }
    if (grid < 0) return;
    if (hipMemsetAsync((char*)d_ws + WS_CTL, 0, CTL_ZERO_BYTES, stream) != hipSuccess) return;
    Args a{};
    for (int i = 0; i < 21; ++i) a.in[i] = (const float*)d_in[i];
    a.out = (float*)d_out; a.ws = (unsigned char*)d_ws;
#if MK_ONE_LAUNCH
    a.ph_lo = 0; a.ph_hi = NPHASE;
    hipLaunchKernelGGL(fwd, dim3(grid), dim3(NTHR), LDS_BYTES, stream, a);
#else
    for (int p = 0; p < NPHASE; ++p) { a.ph_lo = p; a.ph_hi = p + 1; hipLaunchKernelGGL(fwd, dim3(grid), dim3(NTHR), LDS_BYTES, stream, a); }
#endif
}
```
